# Optimizing an MI355X kernel written in HIP

```python
import math
import jax, jax.numpy as jnp
from jax import lax
import numpy as np

D_MODEL = 2048
BATCH = 4
SEQ = 4096
DEPTH = 1

MIX_WIDTH = D_MODEL
HEAD_DIM = 128
ATTN_WIDTH = MIX_WIDTH // 2
ATTN_HEADS = ATTN_WIDTH // HEAD_DIM
KV_HEADS = 2
GQA_GROUP = ATTN_HEADS // KV_HEADS
WINDOW = 128
ATTN_BLOCK = 128
ROPE_THETA = 10000.0

GLA_WIDTH = MIX_WIDTH - ATTN_WIDTH
GLA_HEADS = 4
GLA_KEY_WIDTH = GLA_WIDTH // 2
GLA_DK = GLA_KEY_WIDTH // GLA_HEADS
GLA_DV = GLA_WIDTH // GLA_HEADS
GLA_DECAY_RANK = 16
GLA_GATE_NORMALIZER = 16.0
GLA_CHUNK = 64

D_FF = 5632
CONV_WIDTH = 3
NORM_EPS = 1e-6

IN_WIDTHS = (ATTN_WIDTH,
             KV_HEADS * HEAD_DIM,
             KV_HEADS * HEAD_DIM,
             GLA_KEY_WIDTH,
             GLA_KEY_WIDTH,
             GLA_WIDTH,
             GLA_WIDTH,
             GLA_DECAY_RANK,
             GLA_DECAY_RANK)
IN_TOTAL = sum(IN_WIDTHS)

kernel_name = "hymba_style_swa_gla_convffn_encoder"


def rms_norm(x, g):
    xf = x.astype(jnp.float32)
    y = xf * lax.rsqrt(jnp.mean(xf * xf, axis=-1, keepdims=True) + NORM_EPS)
    return (y * g.astype(jnp.float32)).astype(x.dtype)


def rope(x, pos):
    half = x.shape[-1] // 2
    inv = 1.0 / (ROPE_THETA ** (jnp.arange(half, dtype=jnp.float32) / half))
    ang = pos.astype(jnp.float32)[:, None] * inv[None, :]
    cos = jnp.cos(ang)[:, None, :]
    sin = jnp.sin(ang)[:, None, :]
    xf = x.astype(jnp.float32)
    x1, x2 = xf[..., :half], xf[..., half:]
    return jnp.concatenate([x1 * cos - x2 * sin, x2 * cos + x1 * sin], axis=-1).astype(x.dtype)


def window_attention(q, k, v, sink):
    B, T, HQ, D = q.shape
    nb = T // ATTN_BLOCK
    qb = q.reshape(B, nb, ATTN_BLOCK, KV_HEADS, GQA_GROUP, D)
    pad = ((0, 0), (ATTN_BLOCK, ATTN_BLOCK), (0, 0), (0, 0))
    kb = jnp.pad(k, pad).reshape(B, nb + 2, ATTN_BLOCK, KV_HEADS, D)
    vb = jnp.pad(v, pad).reshape(B, nb + 2, ATTN_BLOCK, KV_HEADS, D)
    kw = jnp.concatenate([kb[:, :-2], kb[:, 1:-1], kb[:, 2:]], axis=2)
    vw = jnp.concatenate([vb[:, :-2], vb[:, 1:-1], vb[:, 2:]], axis=2)
    s = jnp.einsum('bnqhgd,bnshd->bhgnqs', qb, kw).astype(jnp.float32) * (D ** -0.5)
    qi = jnp.arange(ATTN_BLOCK)[:, None]
    sj = jnp.arange(3 * ATTN_BLOCK)[None, :]
    rel = sj - ATTN_BLOCK - qi
    kpos = jnp.arange(nb)[:, None, None] * ATTN_BLOCK - ATTN_BLOCK + sj[None]
    mask = (jnp.abs(rel) <= WINDOW)[None] & (kpos >= 0) & (kpos < T)
    s = jnp.where(mask, s, -jnp.inf)
    sk = sink.astype(jnp.float32).reshape(KV_HEADS, GQA_GROUP)[None, :, :, None, None, None]
    m = jnp.maximum(jnp.max(s, axis=-1, keepdims=True), sk)
    p = jnp.exp(s - m)
    p = p / (jnp.sum(p, axis=-1, keepdims=True) + jnp.exp(sk - m))
    o = jnp.einsum('bhgnqs,bnshd->bnqhgd', p.astype(v.dtype), vw)
    return o.reshape(B, T, HQ * D)


def gla_chunked(q, k, v, g, strict):
    B, H, T, DK = q.shape
    DV = v.shape[-1]
    C = GLA_CHUNK
    n = T // C
    q = q.reshape(B, H, n, C, DK)
    k = k.reshape(B, H, n, C, DK)
    g = g.reshape(B, H, n, C, DK)
    v = v.reshape(B, H, n, C, DV)
    b = jnp.cumsum(g, axis=3)
    b_last = b[:, :, :, -1:, :]
    b_ref = b[:, :, :, C // 2:C // 2 + 1, :]
    a = jnp.einsum('bhnid,bhnjd->bhnij', q * jnp.exp(b - b_ref), k * jnp.exp(b_ref - b))
    mask = jnp.tril(jnp.ones((C, C), dtype=bool), -1 if strict else 0)
    a = jnp.where(mask, a, 0.0)
    o_intra = jnp.einsum('bhnij,bhnje->bhnie', a, v)
    q_in = q * jnp.exp(b)
    k_out = k * jnp.exp(b_last - b)
    chunk_decay = jnp.exp(b_last[:, :, :, 0, :])

    def step(state, inp):
        qc, kc, vc, dc = inp
        o = jnp.einsum('bhid,bhde->bhie', qc, state)
        state = state * dc[..., None] + jnp.einsum('bhjd,bhje->bhde', kc, vc)
        return state, o

    s0 = jnp.zeros((B, H, DK, DV), jnp.float32)
    xs = (jnp.moveaxis(q_in, 2, 0), jnp.moveaxis(k_out, 2, 0),
          jnp.moveaxis(v, 2, 0), jnp.moveaxis(chunk_decay, 2, 0))
    _, o_inter = lax.scan(step, s0, xs)
    o_inter = jnp.moveaxis(o_inter, 0, 2)
    return (o_intra + o_inter).reshape(B, H, T, DV)


def bidirectional_gla(q, k, v, lr_f, lr_b, wa2_f, ba_f, wa2_b, ba_b, gate, out_norm_g):
    B, T, _ = q.shape
    f32 = jnp.float32

    def heads(t, d):
        return jnp.transpose(t.astype(f32).reshape(B, T, GLA_HEADS, d), (0, 2, 1, 3))

    qh = heads(q, GLA_DK) * (GLA_DK ** -0.5)
    kh = heads(k, GLA_DK)
    vh = heads(v, GLA_DV)
    g_f = jax.nn.log_sigmoid((lr_f @ wa2_f + ba_f).astype(f32)) / GLA_GATE_NORMALIZER
    g_b = jax.nn.log_sigmoid((lr_b @ wa2_b + ba_b).astype(f32)) / GLA_GATE_NORMALIZER
    gf = heads(g_f, GLA_DK)
    gb = heads(g_b, GLA_DK)
    o_fwd = gla_chunked(qh, kh, vh, gf, strict=False)
    flip = lambda t: jnp.flip(t, axis=2)
    o_bwd = flip(gla_chunked(flip(qh), flip(kh), flip(vh), flip(gb), strict=True))
    o = jnp.transpose(o_fwd + o_bwd, (0, 2, 1, 3)).astype(v.dtype)
    o = rms_norm(o, out_norm_g)
    o = o * jax.nn.silu(gate.reshape(B, T, GLA_HEADS, GLA_DV))
    return o.reshape(B, T, GLA_WIDTH)


def conv_gated_ffn(h, w_up, conv_w, conv_b, w_down):
    u = h @ w_up
    up_ = jnp.pad(u, ((0, 0), (1, 1), (0, 0)))
    u = up_[:, :-2] * conv_w[0] + up_[:, 1:-1] * conv_w[1] + up_[:, 2:] * conv_w[2] + conv_b
    gate, val = jnp.split(u, 2, axis=-1)
    return (jax.nn.silu(gate) * val) @ w_down


def hybrid_layer(x, norm1_g, w_in, q_norm_g, k_norm_g, sink, wa2_f, ba_f, wa2_b, ba_b,
                 gla_out_norm_g, w_out, norm2_g, w_up, conv_w, conv_b, w_down):
    B, T, _ = x.shape
    pos = jnp.arange(T, dtype=jnp.int32)
    h = rms_norm(x, norm1_g)
    proj = h @ w_in
    offsets = []
    acc = 0
    for w in IN_WIDTHS[:-1]:
        acc += w
        offsets.append(acc)
    q_a, k_a, v_a, q_g, k_g, v_g, gate_g, lr_f, lr_b = jnp.split(proj, offsets, axis=-1)
    qa = rope(rms_norm(q_a.reshape(B, T, ATTN_HEADS, HEAD_DIM), q_norm_g), pos)
    ka = rope(rms_norm(k_a.reshape(B, T, KV_HEADS, HEAD_DIM), k_norm_g), pos)
    va = v_a.reshape(B, T, KV_HEADS, HEAD_DIM)
    o_attn = window_attention(qa, ka, va, sink)
    o_gla = bidirectional_gla(q_g, k_g, v_g, lr_f, lr_b, wa2_f, ba_f, wa2_b, ba_b,
                              gate_g, gla_out_norm_g)
    x = x + jnp.concatenate([o_attn, o_gla], axis=-1) @ w_out
    x = x + conv_gated_ffn(rms_norm(x, norm2_g), w_up, conv_w, conv_b, w_down)
    return x


def setup_inputs(seed: int = 0) -> dict:
    key = jax.random.key(seed)
    ks = jax.random.split(key, 20)
    f32 = jnp.float32
    L = DEPTH

    def nrm(k, shape, scale):
        return jax.random.normal(k, shape, f32) * scale

    return {
        "x": nrm(ks[0], (BATCH, SEQ, D_MODEL), 1.0),
        "norm1_g": 1.0 + nrm(ks[1], (L, D_MODEL), 0.02),
        "w_in": nrm(ks[2], (L, D_MODEL, IN_TOTAL), D_MODEL ** -0.5),
        "attn_q_norm_g": 1.0 + nrm(ks[3], (L, HEAD_DIM), 0.02),
        "attn_k_norm_g": 1.0 + nrm(ks[4], (L, HEAD_DIM), 0.02),
        "attn_sink": nrm(ks[5], (L, ATTN_HEADS), 0.5),
        "gla_wa2_fwd": nrm(ks[6], (L, GLA_DECAY_RANK, GLA_KEY_WIDTH), GLA_DECAY_RANK ** -0.5),
        "gla_ba_fwd": nrm(ks[7], (L, GLA_KEY_WIDTH), 0.1),
        "gla_wa2_bwd": nrm(ks[8], (L, GLA_DECAY_RANK, GLA_KEY_WIDTH), GLA_DECAY_RANK ** -0.5),
        "gla_ba_bwd": nrm(ks[9], (L, GLA_KEY_WIDTH), 0.1),
        "gla_out_norm_g": 1.0 + nrm(ks[10], (L, GLA_DV), 0.02),
        "w_out": nrm(ks[11], (L, MIX_WIDTH, D_MODEL), MIX_WIDTH ** -0.5),
        "norm2_g": 1.0 + nrm(ks[12], (L, D_MODEL), 0.02),
        "w_up": nrm(ks[13], (L, D_MODEL, 2 * D_FF), D_MODEL ** -0.5),
        "conv_w": nrm(ks[14], (L, CONV_WIDTH, 2 * D_FF), CONV_WIDTH ** -0.5),
        "conv_b": nrm(ks[15], (L, 2 * D_FF), 0.02),
        "w_down": nrm(ks[16], (L, D_FF, D_MODEL), D_FF ** -0.5),
    }


def reference(x, norm1_g, w_in, attn_q_norm_g, attn_k_norm_g, attn_sink, gla_wa2_fwd,
              gla_ba_fwd, gla_wa2_bwd, gla_ba_bwd, gla_out_norm_g, w_out, norm2_g,
              w_up, conv_w, conv_b, w_down):
    for l in range(DEPTH):
        x = hybrid_layer(x, norm1_g[l], w_in[l], attn_q_norm_g[l], attn_k_norm_g[l],
                         attn_sink[l], gla_wa2_fwd[l], gla_ba_fwd[l], gla_wa2_bwd[l],
                         gla_ba_bwd[l], gla_out_norm_g[l], w_out[l], norm2_g[l],
                         w_up[l], conv_w[l], conv_b[l], w_down[l])
    return x
```

```cpp
#include <hip/hip_runtime.h>
#include <hip/hip_cooperative_groups.h>
#include <cstdio>
#include <cstdint>
namespace cg = cooperative_groups;

#define LAS __attribute__((address_space(3)))
typedef unsigned short bf16;
typedef unsigned v4u __attribute__((ext_vector_type(4)));
typedef unsigned v2u __attribute__((ext_vector_type(2)));
typedef float f32x4 __attribute__((ext_vector_type(4)));
typedef short bf16x8 __attribute__((ext_vector_type(8)));
typedef short s16x4 __attribute__((ext_vector_type(4)));

namespace pg8 {
#define PG8_LAS __attribute__((address_space(3)))
typedef unsigned short bf16_t;
constexpr int BM = 256, BK = 64, HALF = 128, HTB = HALF * BK * 2, STAGE_BYTES = 8 * HTB, NXCD = 8, WGM = 8;

__host__ __device__ __forceinline__ int lds_byte(int r, int c) { const int st = (r >> 4) * 2 + (c >> 5), rr = r & 15, cc = c & 31, ob = rr * 64 + cc * 2; return st * 1024 + (ob ^ (((ob >> 9) & 1) << 5)); }
__host__ __device__ __forceinline__ void stage_rc(int b, int& R, int& C) { const int st = b / 1024, sb = b % 1024, swz = sb ^ (((sb >> 9) & 1) << 5); R = (st >> 1) * 16 + swz / 64; C = (st & 1) * 32 + (swz % 64) / 2; }
__host__ __device__ __forceinline__ int perm32(int rho) { const int n = rho >> 4, i = rho & 15; return 8 * (i >> 2) + 4 * n + (i & 3); }

struct Unit { int pm, pn; };
struct Gemm { const bf16_t* A; const bf16_t* Bt; int M, N, K; };

struct StaticOrder {
    int nM, nN, nwg, G, c;
    __host__ __device__ void init(int M, int N, int G_, int c_) { nM = M / BM; nN = N / BM; nwg = nM * nN; G = G_; c = c_; }
    __host__ __device__ bool next(int i, Unit& u) const {
        const long L = (long)i * G + c; if (L >= nwg) return false;
        int wgid = (int)L; { const int q = nwg / NXCD, r = nwg % NXCD, xcd = wgid % NXCD, off = wgid / NXCD; wgid = (xcd < r ? xcd * (q + 1) : r * (q + 1) + (xcd - r) * q) + off; }
        const int nig = WGM * nN, gid = wgid / nig, fm = gid * WGM, gsz = (nM - fm) < WGM ? (nM - fm) : WGM;
        u.pm = fm + ((wgid % nig) % gsz); u.pn = (wgid % nig) / gsz; return true;
    }
    __device__ __forceinline__ void a_ready(const Unit&) const {}
    __device__ __forceinline__ void done(const Unit&) const {}
};

__device__ __forceinline__ unsigned cvt_pk_bf16(float lo, float hi) { unsigned r; asm volatile("v_cvt_pk_bf16_f32 %0, %1, %2" : "=v"(r) : "v"(lo), "v"(hi)); return r; }

struct EpiBf16 {
    static constexpr bool PERM = true, AFTER_DRAIN = false;
    bf16_t* O; int ldc;
    __device__ __forceinline__ void operator()(const f32x4 (&acc)[2][2][4][2], const Unit& u, int wr, int wc, int fr, int fq) const {
        const int row0 = u.pm * BM + wr * 64 + fr; const int col0 = u.pn * BM + wc * 32 + 8 * fq;
#pragma unroll
        for (int ai = 0; ai < 2; ++ai)
#pragma unroll
            for (int m = 0; m < 4; ++m) { bf16_t* rowp = O + (size_t)(row0 + ai * HALF + m * 16) * ldc + col0;
#pragma unroll
                for (int bj = 0; bj < 2; ++bj) { const f32x4 v0 = acc[ai][bj][m][0], v1 = acc[ai][bj][m][1];
                    v4u w; w.x = cvt_pk_bf16(v0[0], v0[1]); w.y = cvt_pk_bf16(v0[2], v0[3]); w.z = cvt_pk_bf16(v1[0], v1[1]); w.w = cvt_pk_bf16(v1[2], v1[3]);
                    *(v4u*)(rowp + bj * HALF) = w; } }
    }
};
struct EpiResF32 {
    static constexpr bool PERM = true, AFTER_DRAIN = false;
    float* C; const float* R; int ldc;
    __device__ __forceinline__ void operator()(const f32x4 (&acc)[2][2][4][2], const Unit& u, int wr, int wc, int fr, int fq) const {
        const int row0 = u.pm * BM + wr * 64 + fr, col0 = u.pn * BM + wc * 32 + 8 * fq;
#pragma unroll
        for (int ai = 0; ai < 2; ++ai)
#pragma unroll
            for (int m = 0; m < 4; ++m) { const size_t ro = (size_t)(row0 + ai * HALF + m * 16) * ldc + col0;
#pragma unroll
                for (int bj = 0; bj < 2; ++bj)
#pragma unroll
                    for (int n = 0; n < 2; ++n) { const f32x4 r = *(const f32x4*)(R + ro + bj * HALF + n * 4); *(f32x4*)(C + ro + bj * HALF + n * 4) = acc[ai][bj][m][n] + r; } }
    }
};
struct EpiX1 {
    static constexpr bool PERM = true, AFTER_DRAIN = false;
    const float* R; bf16_t* H2; float* rowss; int ldc;
    __device__ __forceinline__ void operator()(const f32x4 (&acc)[2][2][4][2], const Unit& u, int wr, int wc, int fr, int fq) const {
        const int row0 = u.pm * BM + wr * 64 + fr, col0 = u.pn * BM + wc * 32 + 8 * fq;
#pragma unroll
        for (int ai = 0; ai < 2; ++ai)
#pragma unroll
            for (int m = 0; m < 4; ++m) { const int row = row0 + ai * HALF + m * 16; const size_t ro = (size_t)row * ldc + col0;
                const size_t po = (size_t)((row >> 12) * 4154 + 1 + (row & 4095)) * ldc + col0;
                float ss = 0.f;
#pragma unroll
                for (int bj = 0; bj < 2; ++bj) {
                    const f32x4 r0 = __builtin_nontemporal_load((const f32x4*)(R + ro + bj * HALF)), r1 = __builtin_nontemporal_load((const f32x4*)(R + ro + bj * HALF + 4));
                    const f32x4 v0 = acc[ai][bj][m][0] + r0, v1 = acc[ai][bj][m][1] + r1;
                    v4u w; w.x = cvt_pk_bf16(v0[0], v0[1]); w.y = cvt_pk_bf16(v0[2], v0[3]); w.z = cvt_pk_bf16(v1[0], v1[1]); w.w = cvt_pk_bf16(v1[2], v1[3]);
                    *(v4u*)(H2 + po + bj * HALF) = w;
                    ss += (v0[0] * v0[0] + v0[1] * v0[1]) + (v0[2] * v0[2] + v0[3] * v0[3]) + (v1[0] * v1[0] + v1[1] * v1[1]) + (v1[2] * v1[2] + v1[3] * v1[3]); }
                ss += __shfl_xor(ss, 16); ss += __shfl_xor(ss, 32);
                if (fq == 0) atomicAdd(rowss + row, ss);
            }
    }
};
struct EpiOut {
    static constexpr bool PERM = true, AFTER_DRAIN = false;
    float* C; const bf16_t* H2; int ldc;
    __device__ __forceinline__ void operator()(const f32x4 (&acc)[2][2][4][2], const Unit& u, int wr, int wc, int fr, int fq) const {
        const int row0 = u.pm * BM + wr * 64 + fr, col0 = u.pn * BM + wc * 32 + 8 * fq;
#pragma unroll
        for (int ai = 0; ai < 2; ++ai)
#pragma unroll
            for (int m = 0; m < 4; ++m) { const int row = row0 + ai * HALF + m * 16; const size_t ro = (size_t)row * ldc + col0;
                const size_t po = (size_t)((row >> 12) * 4154 + 1 + (row & 4095)) * ldc + col0;
#pragma unroll
                for (int bj = 0; bj < 2; ++bj) {
                    const v4u h = __builtin_nontemporal_load((const v4u*)(H2 + po + bj * HALF));
                    const f32x4 r0 = (f32x4){__builtin_bit_cast(float, h.x << 16), __builtin_bit_cast(float, h.x & 0xffff0000u), __builtin_bit_cast(float, h.y << 16), __builtin_bit_cast(float, h.y & 0xffff0000u)};
                    const f32x4 r1 = (f32x4){__builtin_bit_cast(float, h.z << 16), __builtin_bit_cast(float, h.z & 0xffff0000u), __builtin_bit_cast(float, h.w << 16), __builtin_bit_cast(float, h.w & 0xffff0000u)};
                    __builtin_nontemporal_store(acc[ai][bj][m][0] + r0, (f32x4*)(C + ro + bj * HALF)); __builtin_nontemporal_store(acc[ai][bj][m][1] + r1, (f32x4*)(C + ro + bj * HALF + 4)); }
            }
    }
};
__device__ __forceinline__ float dpp_f(float oldv, float src, int) { return src + oldv; }
template <int CTRL> __device__ __forceinline__ float dppmov(float oldv, float src) {
    return __builtin_bit_cast(float, __builtin_amdgcn_update_dpp(__builtin_bit_cast(int, oldv), __builtin_bit_cast(int, src), CTRL, 0xf, 0xf, false));
}
template <int CTRL> __device__ __forceinline__ float rormov(float src) {
    return __builtin_bit_cast(float, __builtin_amdgcn_mov_dpp(__builtin_bit_cast(int, src), CTRL, 0xf, 0xf, true));
}
struct EpiConv {
    static constexpr bool PERM = true, AFTER_DRAIN = false;
    bf16_t* act; const float* cw; const float* cb; const float* rowss;
    __device__ __forceinline__ void operator()(const f32x4 (&acc_in)[2][2][4][2], const Unit& u, int wr, int wc, int fr, int fq) const {
        constexpr int NU = 11264, FF = 5632, PB = 4154;
        const int gc0 = u.pn * 128 + wc * 32 + fq * 8;
        f32x4 acc[2][2][4][2];
#pragma unroll
        for (int ai = 0; ai < 2; ++ai)
#pragma unroll
            for (int m = 0; m < 4; ++m) {
                const int p = 62 * (4 * u.pm + 2 * ai + wr) + 16 * m + fr, b = p / PB, q = p - b * PB;
                float rr = 0.f;
                if (q >= 1 && q <= 4096 && b < 4) rr = __builtin_amdgcn_rsqf(rowss[b * 4096 + q - 1] * (1.f / 2048.f) + 1e-6f);
#pragma unroll
                for (int bj = 0; bj < 2; ++bj)
#pragma unroll
                    for (int n = 0; n < 2; ++n) acc[ai][bj][m][n] = acc_in[ai][bj][m][n] * rr;
            }
        unsigned half0[2][4][2];
#pragma unroll
        for (int n = 0; n < 2; ++n) {
            const int gc = gc0 + 4 * n;
            const f32x4 wg0 = *(const f32x4*)(cw + gc), wg1 = *(const f32x4*)(cw + NU + gc), wg2 = *(const f32x4*)(cw + 2 * NU + gc), bg = *(const f32x4*)(cb + gc);
            const f32x4 wv0 = *(const f32x4*)(cw + FF + gc), wv1 = *(const f32x4*)(cw + NU + FF + gc), wv2 = *(const f32x4*)(cw + 2 * NU + FF + gc), bv = *(const f32x4*)(cb + FF + gc);
#pragma unroll
            for (int ai = 0; ai < 2; ++ai) {
                const int slab = 4 * u.pm + 2 * ai + wr, p0 = 62 * slab;
#pragma unroll
                for (int m = 0; m < 4; ++m) {
                    float o[4];
#pragma unroll
                    for (int x = 0; x < 4; ++x) {
                        const float gcur = acc[ai][0][m][n][x], vcur = acc[ai][1][m][n][x];
                        const float gtp = (m > 0 && fr == 15) ? acc[ai][0][m - 1][n][x] : gcur, vtp = (m > 0 && fr == 15) ? acc[ai][1][m - 1][n][x] : vcur;
                        const float gtn = (m < 3 && fr == 0) ? acc[ai][0][m + 1][n][x] : gcur, vtn = (m < 3 && fr == 0) ? acc[ai][1][m + 1][n][x] : vcur;
                        const float gp = rormov<0x121>(gtp), gn = rormov<0x12F>(gtn);
                        const float vp = rormov<0x121>(vtp), vn = rormov<0x12F>(vtn);
                        const float Gv = wg0[x] * gp + wg1[x] * gcur + wg2[x] * gn + bg[x];
                        const float Vv = wv0[x] * vp + wv1[x] * vcur + wv2[x] * vn + bv[x];
                        const float sg = Gv * __builtin_amdgcn_rcpf(1.f + __builtin_amdgcn_exp2f(-1.4426950408889634f * Gv));
                        o[x] = sg * Vv;
                    }
                    if (n == 0) { half0[ai][m][0] = cvt_pk_bf16(o[0], o[1]); half0[ai][m][1] = cvt_pk_bf16(o[2], o[3]); }
                    else {
                        const int rs = 16 * m + fr, p = p0 + rs, b = p / PB, q = p - b * PB;
                        if (rs >= 1 && rs <= 62 && q >= 1 && q <= 4096 && b < 4) {
                            v4u w; w.x = half0[ai][m][0]; w.y = half0[ai][m][1]; w.z = cvt_pk_bf16(o[0], o[1]); w.w = cvt_pk_bf16(o[2], o[3]);
                            *(v4u*)(act + (size_t)(b * 4096 + q - 1) * FF + gc0) = w;
                        }
                    }
                }
            }
        }
    }
};

template <class Epi, class Sched, bool ALIGN_EPI, bool SLAB>
__device__ __forceinline__ void gemm_phase(PG8_LAS unsigned char* lds, const Gemm g, const Sched& S, const Epi& E) {
    const int tid = threadIdx.x, wid = __builtin_amdgcn_readfirstlane(tid >> 6), lane = tid & 63, wr = wid >> 2, wc = wid & 3, fr = lane & 15, fq = lane >> 4;
    const int K = g.K, nt = K / BK;
    unsigned voffA[2], voffB[2];
#pragma unroll
    for (int i = 0; i < 2; ++i) { int R, C; stage_rc(tid * 16 + i * 8192, R, C); const int Rb = Epi::PERM ? ((R & ~31) + perm32(R & 31)) : R;
        const int Ra = SLAB ? (R - 2 * (R >> 6)) : R;
        voffA[i] = (unsigned)(Ra * K + C) * 2u; voffB[i] = (unsigned)(Rb * K + C) * 2u; }
    const size_t kstep = (size_t)(BK * 2);
    const size_t hstepB = (size_t)HALF * K * 2, tstepB = 2 * hstepB;
    const size_t hstepA = SLAB ? (size_t)124 * K * 2 : hstepB, tstepA = 2 * hstepA;
    const unsigned ldsw = (unsigned)wid * 1024u;
    const int aoff = lds_byte(wr * 64 + fr, fq * 8), boff = lds_byte(wc * 32 + fr, fq * 8);
#define PG8_SA(b, h) (((b) * 2 + (h)) * HTB)
#define PG8_SB(b, h) ((4 + (b) * 2 + (h)) * HTB)
#define PG8_STAGE(bufoff, gbase, voff) do { _Pragma("unroll") for (int _i = 0; _i < 2; ++_i) \
        __builtin_amdgcn_global_load_lds((const unsigned*)((const char*)(gbase) + (voff)[_i]), (PG8_LAS unsigned*)(lds + (bufoff) + ldsw + _i * 8192), 16, 0, 0); } while (0)
#define PG8_LDA(dst, b, h) do { _Pragma("unroll") for (int m = 0; m < 4; ++m) _Pragma("unroll") for (int k = 0; k < 2; ++k) dst[m][k] = *(const PG8_LAS bf16x8*)(lds + PG8_SA(b, h) + aoff + m * 2048 + k * 1024); } while (0)
#define PG8_LDB(dst, b, h) do { _Pragma("unroll") for (int n = 0; n < 2; ++n) _Pragma("unroll") for (int k = 0; k < 2; ++k) dst[n][k] = *(const PG8_LAS bf16x8*)(lds + PG8_SB(b, h) + boff + n * 2048 + k * 1024); } while (0)
#define PG8_MMA(ai, bj, At, Bt) do { __builtin_amdgcn_s_setprio(1); _Pragma("unroll") for (int m = 0; m < 4; ++m) _Pragma("unroll") for (int n = 0; n < 2; ++n) _Pragma("unroll") for (int k = 0; k < 2; ++k) \
        acc[ai][bj][m][n] = __builtin_amdgcn_mfma_f32_16x16x32_bf16(Bt[n][k], At[m][k], acc[ai][bj][m][n], 0, 0, 0); __builtin_amdgcn_s_setprio(0); } while (0)
#define PG8_WAIT_V(n) asm volatile("s_waitcnt vmcnt(" #n ")" ::: "memory")
#define PG8_WAIT_L(n) asm volatile("s_waitcnt lgkmcnt(" #n ")" ::: "memory")
#define PG8_BAR __builtin_amdgcn_s_barrier()
#define PG8_SCHED __builtin_amdgcn_sched_barrier(0)
    Unit cur, nxt; int ui = 0;
    if (!S.next(0, cur)) return;
    f32x4 acc[2][2][4][2];
#pragma unroll
    for (int a = 0; a < 2; ++a)
#pragma unroll
        for (int b = 0; b < 2; ++b)
#pragma unroll
            for (int m = 0; m < 4; ++m)
#pragma unroll
                for (int n = 0; n < 2; ++n) acc[a][b][m][n] = (f32x4){0.f, 0.f, 0.f, 0.f};
    bf16x8 At[4][2], B0[2][2], B1[2][2];
    const char* cA = (const char*)g.A + (size_t)cur.pm * tstepA; const char* cB = (const char*)g.Bt + (size_t)cur.pn * tstepB;
    S.a_ready(cur);
    PG8_STAGE(PG8_SB(0, 0), cB, voffB); PG8_STAGE(PG8_SB(0, 1), cB + hstepB, voffB); PG8_STAGE(PG8_SA(0, 0), cA, voffA); PG8_STAGE(PG8_SA(0, 1), cA + hstepA, voffA);
    if (wr == 1) PG8_BAR;
    PG8_WAIT_V(2); PG8_BAR;
    PG8_STAGE(PG8_SB(1, 0), cB + kstep, voffB); PG8_STAGE(PG8_SA(1, 0), cA + kstep, voffA); PG8_STAGE(PG8_SB(1, 1), cB + hstepB + kstep, voffB);
    PG8_WAIT_V(6); PG8_BAR;
    for (;;) {
        const bool has_next = S.next(ui + 1, nxt);
        const char* nA = has_next ? (const char*)g.A + (size_t)nxt.pm * tstepA : cA; const char* nB = has_next ? (const char*)g.Bt + (size_t)nxt.pn * tstepB : cB;
        for (int t = 0; t < nt; t += 2) {
            const bool last = (t == nt - 2);
            const char* a1 = cA + (size_t)(t + 1) * kstep;
            const char* a2 = last ? nA : cA + (size_t)(t + 2) * kstep; const char* b2 = last ? nB : cB + (size_t)(t + 2) * kstep;
            const char* a3 = a2 + kstep; const char* b3 = b2 + kstep;
            if (last && has_next) S.a_ready(nxt);
            PG8_LDB(B0, 0, 0); PG8_LDB(B1, 0, 1); PG8_SCHED; PG8_LDA(At, 0, 0); PG8_STAGE(PG8_SA(1, 1), a1 + hstepA, voffA);
            PG8_WAIT_V(8); PG8_WAIT_L(0); PG8_BAR; PG8_MMA(0, 0, At, B0); PG8_MMA(0, 1, At, B1); PG8_BAR; PG8_SCHED;
            PG8_LDA(At, 0, 1); PG8_STAGE(PG8_SB(0, 0), b2, voffB); PG8_STAGE(PG8_SB(0, 1), b2 + hstepB, voffB); PG8_STAGE(PG8_SA(0, 0), a2, voffA);
            PG8_WAIT_V(8); PG8_WAIT_L(0); PG8_BAR; PG8_MMA(1, 0, At, B0); PG8_MMA(1, 1, At, B1); PG8_BAR; PG8_SCHED;
            PG8_LDB(B0, 1, 0); PG8_LDB(B1, 1, 1); PG8_SCHED; PG8_LDA(At, 1, 0); PG8_STAGE(PG8_SA(0, 1), a2 + hstepA, voffA);
            PG8_WAIT_V(8); PG8_WAIT_L(0); PG8_BAR; PG8_MMA(0, 0, At, B0); PG8_MMA(0, 1, At, B1); PG8_BAR; PG8_SCHED;
            PG8_LDA(At, 1, 1); PG8_STAGE(PG8_SB(1, 0), b3, voffB); PG8_STAGE(PG8_SB(1, 1), b3 + hstepB, voffB); PG8_STAGE(PG8_SA(1, 0), a3, voffA);
            PG8_WAIT_V(8); PG8_WAIT_L(0); PG8_BAR; PG8_MMA(1, 0, At, B0); PG8_MMA(1, 1, At, B1); PG8_BAR; PG8_SCHED;
        }
        if constexpr (ALIGN_EPI) { if (wr == 0) PG8_BAR; }
        E(acc, cur, wr, wc, fr, fq); S.done(cur);
        if (!has_next) break;
#pragma unroll
        for (int a = 0; a < 2; ++a)
#pragma unroll
            for (int b = 0; b < 2; ++b)
#pragma unroll
                for (int m = 0; m < 4; ++m)
#pragma unroll
                    for (int n = 0; n < 2; ++n) acc[a][b][m][n] = (f32x4){0.f, 0.f, 0.f, 0.f};
        cur = nxt; cA = nA; cB = nB; ++ui;
        if constexpr (ALIGN_EPI) { if (wr == 1) PG8_BAR; }
    }
    PG8_WAIT_V(0);
    if constexpr (!ALIGN_EPI) { if (wr == 0) PG8_BAR; }
    PG8_BAR;
#undef PG8_SA
#undef PG8_SB
#undef PG8_STAGE
#undef PG8_LDA
#undef PG8_LDB
#undef PG8_MMA
#undef PG8_WAIT_V
#undef PG8_WAIT_L
#undef PG8_BAR
#undef PG8_SCHED
}
}

constexpr int NWAVES = 8, NTHR = 512;
constexpr int BATCH = 4, T = 4096, D = 2048, M = BATCH * T;
constexpr int NPROJ = 4640, NPROJ_P = 4864;
constexpr int DFF = 5632, NUP = 11264;
constexpr int C_QA = 0, C_KA = 1024, C_VA = 1280, C_QG = 1536, C_KG = 2048, C_VG = 2560, C_GG = 3584, C_LRF = 4608;
constexpr int PB = 4154, H2ROWS = 67 * 248 + 2;
constexpr float EPS = 1e-6f;
constexpr float LOG2E = 1.4426950408889634f;
constexpr float QSCALE = 0.08838834764831845f * LOG2E;
constexpr float GLA_SC = 0.08838834764831845f;

constexpr size_t MiB = 1u << 20;
constexpr size_t WS_RSS = 65536;
constexpr size_t WS_WIN = 1 * MiB, WS_WOUT = 20 * MiB, WS_WUP = 28 * MiB, WS_WDN = 72 * MiB;
constexpr size_t WS_H = 96 * MiB;
constexpr size_t WS_QA = 96 * MiB, WS_KOT = 128 * MiB;
constexpr size_t WS_PROJ = 160 * MiB;
constexpr size_t WS_MIX = 312 * MiB;
constexpr size_t WS_AB = 376 * MiB, WS_QI = 392 * MiB, WS_DV = 424 * MiB, WS_VTG = 426 * MiB, WS_KA = 458 * MiB, WS_VTA = 466 * MiB, WS_END = 474 * MiB;
constexpr size_t WS_H2 = 160 * MiB;
constexpr size_t WS_ACT = 232 * MiB;
static_assert(WS_H2 + (size_t)H2ROWS * D * 2 <= WS_ACT && WS_ACT + (size_t)M * DFF * 2 <= WS_END, "ws map");

constexpr int LDS_BYTES = 147456;
constexpr int LDS_XB = LDS_BYTES - 1024;
constexpr int W_UP_EARLY = 3072;

typedef float f32x2_t __attribute__((ext_vector_type(2)));
typedef __bf16 bf16x2_t __attribute__((ext_vector_type(2)));
__device__ __forceinline__ unsigned pk2(float lo, float hi) { f32x2_t v = {lo, hi}; bf16x2_t b = __builtin_convertvector(v, bf16x2_t); return __builtin_bit_cast(unsigned, b); }
__device__ __forceinline__ unsigned f2bf(float f) { return pk2(f, 0.f) & 0xffffu; }
__device__ __forceinline__ float bflo(unsigned w) { return __builtin_bit_cast(float, w << 16); }
__device__ __forceinline__ float bfhi(unsigned w) { return __builtin_bit_cast(float, w & 0xffff0000u); }
__device__ __forceinline__ float bf2f(unsigned short b) { return __builtin_bit_cast(float, (unsigned)b << 16); }
__device__ __forceinline__ float wave_sum(float v) {
#pragma unroll
    for (int o = 1; o < 64; o <<= 1) v += __shfl_xor(v, o);
    return v;
}
#define LDS_WAIT() asm volatile("s_waitcnt lgkmcnt(0)" ::: "memory")
#define MFMA16(a, b, c) __builtin_amdgcn_mfma_f32_16x16x32_bf16((a), (b), (c), 0, 0, 0)

struct Args {
    const float* in[17]; float* out; unsigned char* ws; int ph_lo, ph_hi;
};

__device__ __forceinline__ void transpose_item(const float* W, int K, int N, bf16* WT, int mode, LAS float* scr, int item, int lane, const float* kgain = nullptr) {
    const int nblk = N / 32, kb = item / nblk, nb = item % nblk, k0 = 64 * kb, n0 = 32 * nb;
    int drow0 = n0;
    if (mode == 1) drow0 = (n0 < DFF) ? (n0 / 128) * 256 + (n0 % 128) : ((n0 - DFF) / 128) * 256 + 128 + ((n0 - DFF) % 128);
    float tv[32];
#pragma unroll
    for (int i = 0; i < 32; ++i) { const int kk = 2 * i + (lane >> 5); tv[i] = __builtin_nontemporal_load(W + (size_t)(k0 + kk) * N + n0 + (lane & 31)); }
    if (kgain) {
#pragma unroll
        for (int i = 0; i < 32; ++i) tv[i] *= kgain[k0 + 2 * i + (lane >> 5)];
    }
#pragma unroll
    for (int i = 0; i < 32; ++i) { const int kk = 2 * i + (lane >> 5); scr[kk * 33 + (lane & 31)] = tv[i]; }
    LDS_WAIT(); asm volatile("" ::: "memory");
    const int c = lane & 7;
#pragma unroll
    for (int j = 0; j < 4; ++j) { const int n = (lane >> 3) + 8 * j; const LAS float* s = scr + (8 * c) * 33 + n;
        v4u o; o.x = pk2(s[0 * 33], s[1 * 33]); o.y = pk2(s[2 * 33], s[3 * 33]); o.z = pk2(s[4 * 33], s[5 * 33]); o.w = pk2(s[6 * 33], s[7 * 33]);
        *(v4u*)(WT + (size_t)(drow0 + n) * K + k0 + 8 * c) = o; }
    LDS_WAIT(); asm volatile("" ::: "memory");
}
__device__ __forceinline__ void rms_row_to_bf16(const float* xrow, const float* gain, bf16* orow, int lane) {
    const f32x4* xr = (const f32x4*)xrow + lane; const f32x4* gr = (const f32x4*)gain + lane;
    f32x4 v[8]; float s = 0.f;
#pragma unroll
    for (int j = 0; j < 8; ++j) { v[j] = __builtin_nontemporal_load(xr + 64 * j); s += (v[j].x * v[j].x + v[j].y * v[j].y) + (v[j].z * v[j].z + v[j].w * v[j].w); }
    const float r = 1.0f / sqrtf(wave_sum(s) * (1.f / D) + EPS);
    v2u* o8 = (v2u*)orow + lane;
#pragma unroll
    for (int j = 0; j < 8; ++j) { const f32x4 g = gr[64 * j]; v2u w; w.x = pk2(v[j].x * r * g.x, v[j].y * r * g.y); w.y = pk2(v[j].z * r * g.z, v[j].w * r * g.w); o8[64 * j] = w; }
}

__device__ __forceinline__ void gla_prep_block(LAS unsigned char* L, int item0, int istride, const bf16* proj, const float* wa2f, const float* baf, const float* wa2b, const float* bab,
                                              bf16* Abuf, bf16* QIb, bf16* KOTb, float* DVb) {
    const int tid = threadIdx.x, lane = tid & 63, w = __builtin_amdgcn_readfirstlane(tid >> 6);
    LAS unsigned char* Qs = L; LAS unsigned char* Ks = L + 17408; LAS unsigned char* Gs = L + 34816; LAS float* Tot = (LAS float*)(L + 68608);
    LAS float* LRs = (LAS float*)(L + 70656); LAS unsigned char* QEs = L + 78848; LAS unsigned char* KEs = L + 96256; LAS unsigned char* KOs = L + 113664;
    v4u pq[2], pk[2]; v2u plr;
    bf16x8 wBf = (bf16x8){0, 0, 0, 0, 0, 0, 0, 0}, wBb = wBf; float biasf = 0.f, biasb = 0.f; int hprev = -1;
#define GP_LOAD(it_) do { const int b_ = (it_) >> 8, h_ = ((it_) >> 6) & 3, n_ = (it_) & 63, tk_ = b_ * T + n_ * 64; \
        _Pragma("unroll") for (int i_ = 0; i_ < 2; ++i_) { const int ch_ = tid + 512 * i_, r_ = ch_ >> 4, c_ = ch_ & 15; \
            pq[i_] = __builtin_nontemporal_load((const v4u*)(proj + (size_t)(tk_ + r_) * NPROJ_P + C_QG + h_ * 128 + c_ * 8)); \
            pk[i_] = __builtin_nontemporal_load((const v4u*)(proj + (size_t)(tk_ + r_) * NPROJ_P + C_KG + h_ * 128 + c_ * 8)); } \
        { const int idx_ = tid * 4, dir_ = idx_ >> 10, r_ = (idx_ >> 4) & 63, c_ = idx_ & 15; \
          plr = *(const v2u*)(proj + (size_t)(tk_ + r_) * NPROJ_P + C_LRF + dir_ * 16 + c_); } } while (0)
    if (item0 < 1024) GP_LOAD(item0);
#pragma unroll 1
  for (int item = item0; item < 1024; item += istride) {
    const int b = item >> 8, h = (item >> 6) & 3, n = item & 63;
    if (h != hprev) { hprev = h; const int d = h * 128 + 16 * w + (lane & 15), lg = lane >> 4;
        if (lg < 2) { float a[8], c[8];
#pragma unroll
            for (int j = 0; j < 8; ++j) { a[j] = wa2f[(lg * 8 + j) * 512 + d]; c[j] = wa2b[(lg * 8 + j) * 512 + d]; }
            v4u pa, pc; pa.x = pk2(a[0], a[1]); pa.y = pk2(a[2], a[3]); pa.z = pk2(a[4], a[5]); pa.w = pk2(a[6], a[7]);
            pc.x = pk2(c[0], c[1]); pc.y = pk2(c[2], c[3]); pc.z = pk2(c[4], c[5]); pc.w = pk2(c[6], c[7]);
            wBf = __builtin_bit_cast(bf16x8, pa); wBb = __builtin_bit_cast(bf16x8, pc); }
        biasf = baf[d]; biasb = bab[d]; }
    __syncthreads();
#pragma unroll
    for (int i = 0; i < 2; ++i) { const int ch = tid + 512 * i, r = ch >> 4, c = ch & 15;
        *(LAS v4u*)(Qs + r * 272 + c * 16) = pq[i]; *(LAS v4u*)(Ks + r * 272 + c * 16) = pk[i]; }
    { const int idx = tid * 4, dir = idx >> 10, r = (idx >> 4) & 63, c = idx & 15;
      *(LAS v2u*)((LAS unsigned char*)LRs + (dir * 64 + r) * 32 + c * 2) = plr; }
    if (item + istride < 1024) GP_LOAD(item + istride);
    __syncthreads();
#pragma unroll 1
    for (int dir = 0; dir < 2; ++dir) {
        const int ci = (((b * 4 + h) * 2 + dir) * 64 + n);
        {
            const int dl = lane & 15, lg = lane >> 4;
            const float bias = dir ? biasb : biasf;
            float g[4][4];
#pragma unroll
            for (int tt = 0; tt < 4; ++tt) {
                bf16x8 a = (bf16x8){0, 0, 0, 0, 0, 0, 0, 0};
                if (lg < 2) a = *(const LAS bf16x8*)((LAS unsigned char*)LRs + (dir * 64 + 16 * tt + dl) * 32 + lg * 16);
                const f32x4 z4 = MFMA16(a, dir ? wBb : wBf, ((f32x4){0.f, 0.f, 0.f, 0.f}));
#pragma unroll
                for (int jj = 0; jj < 4; ++jj) { const float z = z4[jj] + bias; g[tt][jj] = (fminf(z, 0.f) - __logf(1.f + __expf(-fabsf(z)))) * (1.f / 16.f); }
            }
            float carry = 0.f;
#pragma unroll
            for (int k = 0; k < 4; ++k) {
                const int tt = dir ? 3 - k : k;
                float p[4];
                if (dir == 0) { p[0] = g[tt][0]; p[1] = p[0] + g[tt][1]; p[2] = p[1] + g[tt][2]; p[3] = p[2] + g[tt][3]; }
                else { p[3] = g[tt][3]; p[2] = p[3] + g[tt][2]; p[1] = p[2] + g[tt][1]; p[0] = p[1] + g[tt][0]; }
                const float gt = dir ? p[0] : p[3];
                const float t0 = __shfl(gt, dl), t1 = __shfl(gt, dl + 16), t2 = __shfl(gt, dl + 32), t3 = __shfl(gt, dl + 48);
                float excl;
                if (dir == 0) excl = (lg > 0 ? t0 : 0.f) + (lg > 1 ? t1 : 0.f) + (lg > 2 ? t2 : 0.f);
                else excl = (lg < 3 ? t3 : 0.f) + (lg < 2 ? t2 : 0.f) + (lg < 1 ? t1 : 0.f);
                const float base = carry + excl;
#pragma unroll
                for (int jj = 0; jj < 4; ++jj) *(LAS float*)(Gs + (16 * tt + 4 * lg + jj) * 528 + (16 * w + dl) * 4) = base + p[jj];
                carry += (t0 + t1) + (t2 + t3);
            }
            __syncthreads();
        }
        {
            const int t = tid >> 3, d0 = (tid & 7) * 16;
            const int tref = dir ? 31 : 32, tlast = dir ? 0 : 63;
#pragma unroll
            for (int hf = 0; hf < 2; ++hf) {
                const int dd = d0 + 8 * hf;
                const v4u q8 = *(const LAS v4u*)(Qs + t * 272 + dd * 2), k8 = *(const LAS v4u*)(Ks + t * 272 + dd * 2);
                float qv[8], kv[8], cc[8], cr[8], cl[8];
                qv[0] = bflo(q8.x); qv[1] = bfhi(q8.x); qv[2] = bflo(q8.y); qv[3] = bfhi(q8.y); qv[4] = bflo(q8.z); qv[5] = bfhi(q8.z); qv[6] = bflo(q8.w); qv[7] = bfhi(q8.w);
                kv[0] = bflo(k8.x); kv[1] = bfhi(k8.x); kv[2] = bflo(k8.y); kv[3] = bfhi(k8.y); kv[4] = bflo(k8.z); kv[5] = bfhi(k8.z); kv[6] = bflo(k8.w); kv[7] = bfhi(k8.w);
#pragma unroll
                for (int x4 = 0; x4 < 2; ++x4) {
                    const f32x4 a = *(const LAS f32x4*)(Gs + t * 528 + (dd + 4 * x4) * 4), r4 = *(const LAS f32x4*)(Gs + tref * 528 + (dd + 4 * x4) * 4), l4 = *(const LAS f32x4*)(Gs + tlast * 528 + (dd + 4 * x4) * 4);
#pragma unroll
                    for (int x = 0; x < 4; ++x) { cc[4 * x4 + x] = a[x]; cr[4 * x4 + x] = r4[x]; cl[4 * x4 + x] = l4[x]; }
                }
                float qe[8], ke[8], qi[8], ko[8];
#pragma unroll
                for (int x = 0; x < 8; ++x) { const float qq = qv[x] * GLA_SC;
                    qe[x] = qq * __expf(cc[x] - cr[x]); ke[x] = kv[x] * __expf(cr[x] - cc[x]); qi[x] = qq * __expf(cc[x]); ko[x] = kv[x] * __expf(cl[x] - cc[x]); }
                v4u o;
                o.x = pk2(qe[0], qe[1]); o.y = pk2(qe[2], qe[3]); o.z = pk2(qe[4], qe[5]); o.w = pk2(qe[6], qe[7]); *(LAS v4u*)(QEs + t * 272 + dd * 2) = o;
                o.x = pk2(ke[0], ke[1]); o.y = pk2(ke[2], ke[3]); o.z = pk2(ke[4], ke[5]); o.w = pk2(ke[6], ke[7]); *(LAS v4u*)(KEs + t * 272 + dd * 2) = o;
                o.x = pk2(ko[0], ko[1]); o.y = pk2(ko[2], ko[3]); o.z = pk2(ko[4], ko[5]); o.w = pk2(ko[6], ko[7]); *(LAS v4u*)(KOs + t * 272 + dd * 2) = o;
                o.x = pk2(qi[0], qi[1]); o.y = pk2(qi[2], qi[3]); o.z = pk2(qi[4], qi[5]); o.w = pk2(qi[6], qi[7]); *(v4u*)(QIb + ((size_t)ci * 64 + t) * 128 + dd) = o;
            }
            if (tid < 128) DVb[(size_t)ci * 128 + tid] = __expf(*(const LAS float*)(Gs + tlast * 528 + tid * 4));
            __syncthreads();
        }
        {
            const int d = tid >> 2, tq = tid & 3;
            unsigned short v[16];
#pragma unroll
            for (int i = 0; i < 16; ++i) v[i] = *(const LAS unsigned short*)(KOs + (tq * 16 + i) * 272 + d * 2);
            v4u o0, o1;
            o0.x = v[0] | ((unsigned)v[1] << 16); o0.y = v[2] | ((unsigned)v[3] << 16); o0.z = v[4] | ((unsigned)v[5] << 16); o0.w = v[6] | ((unsigned)v[7] << 16);
            o1.x = v[8] | ((unsigned)v[9] << 16); o1.y = v[10] | ((unsigned)v[11] << 16); o1.z = v[12] | ((unsigned)v[13] << 16); o1.w = v[14] | ((unsigned)v[15] << 16);
            bf16* dst = KOTb + ((size_t)ci * 128 + d) * 64 + tq * 16;
            *(v4u*)dst = o0; *(v4u*)(dst + 8) = o1;
        }
        {
#pragma unroll
            for (int tt = 0; tt < 2; ++tt) {
                const int tile = 2 * w + tt, jt = tile >> 2, it = tile & 3;
                f32x4 acc = (f32x4){0.f, 0.f, 0.f, 0.f};
#pragma unroll
                for (int kk = 0; kk < 4; ++kk) {
                    const bf16x8 a = *(const LAS bf16x8*)(KEs + (16 * jt + (lane & 15)) * 272 + (32 * kk + (lane >> 4) * 8) * 2);
                    const bf16x8 bq = *(const LAS bf16x8*)(QEs + (16 * it + (lane & 15)) * 272 + (32 * kk + (lane >> 4) * 8) * 2);
                    acc = MFMA16(a, bq, acc);
                }
                const int i = 16 * it + (lane & 15), jb = 16 * jt + (lane >> 4) * 4;
                float o[4];
#pragma unroll
                for (int jj = 0; jj < 4; ++jj) { const int j = jb + jj; const bool keep = dir ? (j > i) : (j <= i); o[jj] = keep ? acc[jj] : 0.f; }
                v2u wv2; wv2.x = pk2(o[0], o[1]); wv2.y = pk2(o[2], o[3]);
                *(v2u*)(Abuf + ((size_t)ci * 64 + i) * 64 + jb) = wv2;
            }
        }
        __syncthreads();
    }
  }
#undef GP_LOAD
}

template <bool TCONV> __device__ __forceinline__ void gla_scan_item(LAS unsigned char* L, int wi, const bf16* Abuf, const bf16* QIb, const bf16* KOTb, const float* DVb, const bf16* VTG, bf16* of, bf16* ob,
                                              const float* w_up, const float* kgain, bf16* Wt_up, int tgw, int tngw) {
    const int tid = threadIdx.x, lane = tid & 63, w = __builtin_amdgcn_readfirstlane(tid >> 6);
    const int chain = wi >> 2, sl = wi & 3, dir = chain & 1, bh = chain >> 1, b = bh >> 2, h = bh & 3;
    bf16* odir = dir ? ob : of;
    constexpr int BUFB = 54784, OA = 0, OQ = 9216, OK_ = 26624, OV = 45056, ODV = 54272, OST = 2 * BUFB, STB = 17408;
    v4u rA[2], rQ[2][2], rK[2][2], rV[2]; float rD[2];
#define GS_LOAD(s_, nn) do { const size_t ci_ = (size_t)chain * 64 + (nn); \
        rA[s_] = *(const v4u*)(Abuf + (ci_ * 64 + (tid >> 3)) * 64 + (tid & 7) * 8); \
        _Pragma("unroll") for (int i_ = 0; i_ < 2; ++i_) { const int ch_ = tid + 512 * i_; \
            rQ[s_][i_] = *(const v4u*)(QIb + (ci_ * 64 + (ch_ >> 4)) * 128 + (ch_ & 15) * 8); \
            rK[s_][i_] = *(const v4u*)(KOTb + (ci_ * 128 + (ch_ >> 3)) * 64 + (ch_ & 7) * 8); } \
        rV[s_] = *(const v4u*)(VTG + (((size_t)bh * 64 + (nn)) * 256 + sl * 64 + (tid >> 3)) * 64 + (tid & 7) * 8); \
        rD[s_] = DVb[ci_ * 128 + (tid & 127)]; } while (0)
#define GS_STORE(s_, bi) do { LAS unsigned char* B_ = L + (bi) * BUFB; \
        *(LAS v4u*)(B_ + OA + (tid >> 3) * 144 + (tid & 7) * 16) = rA[s_]; \
        _Pragma("unroll") for (int i_ = 0; i_ < 2; ++i_) { const int ch_ = tid + 512 * i_; \
            *(LAS v4u*)(B_ + OQ + (ch_ >> 4) * 272 + (ch_ & 15) * 16) = rQ[s_][i_]; \
            *(LAS v4u*)(B_ + OK_ + (ch_ >> 3) * 144 + (ch_ & 7) * 16) = rK[s_][i_]; } \
        *(LAS v4u*)(B_ + OV + (tid >> 3) * 144 + (tid & 7) * 16) = rV[s_]; \
        if (tid < 128) *(LAS float*)(B_ + ODV + tid * 4) = rD[s_]; } while (0)
    __syncthreads();
    for (int i = tid; i < STB / 4; i += NTHR) ((LAS unsigned*)(L + OST))[i] = 0u;
    f32x4 S[4];
#pragma unroll
    for (int e = 0; e < 4; ++e) S[e] = (f32x4){0.f, 0.f, 0.f, 0.f};
    { const int n0 = dir ? 63 : 0; GS_LOAD(0, n0); GS_STORE(0, 0); const int n1 = dir ? 62 : 1; GS_LOAD(1, n1); }
    __syncthreads();
    const int it = w >> 1, eh = w & 1;
    constexpr int I_UPC = (D / 64) * (NUP / 32);
    float tv[32], tl[8]; int tk0 = 0, tdrow = 0, tl_k = 0; bool tvalid = false, tl_valid = false; const float* twp = w_up; bf16* tl_dst = Wt_up;
#pragma unroll 1
    for (int step4 = 0; step4 < 16; ++step4) {
#pragma unroll
      for (int par = 0; par < 4; ++par) {
        const int step = 4 * step4 + par, cur = par & 1;
        if (TCONV && par == 0 && tl_valid) { const f32x4 g0_ = *(const f32x4*)(kgain + tl_k), g1_ = *(const f32x4*)(kgain + tl_k + 4); v4u o_;
            o_.x = pk2(tl[0] * g0_[0], tl[1] * g0_[1]); o_.y = pk2(tl[2] * g0_[2], tl[3] * g0_[3]); o_.z = pk2(tl[4] * g1_[0], tl[5] * g1_[1]); o_.w = pk2(tl[6] * g1_[2], tl[7] * g1_[3]);
            *(v4u*)tl_dst = o_; tl_valid = false; }
        const int n = dir ? 63 - step : step;
        { const int nn = dir ? (n >= 2 ? n - 2 : 0) : (n <= 61 ? n + 2 : 63); GS_LOAD(par & 1, nn); }
        if constexpr (TCONV) {
            if (par == 0) { int it_ = tgw + step4 * tngw; tvalid = tgw >= 0 && it_ < I_UPC; it_ = tvalid ? it_ : I_UPC - 1;
                const int kb_ = it_ / (NUP / 32), nb_ = it_ - kb_ * (NUP / 32); tk0 = 64 * kb_ + 32 * (lane >> 5); const int n0_ = 32 * nb_;
                tdrow = ((n0_ < DFF) ? (n0_ / 128) * 256 + (n0_ % 128) : ((n0_ - DFF) / 128) * 256 + 128 + ((n0_ - DFF) % 128)) + (lane & 31);
                twp = w_up + (size_t)tk0 * NUP + n0_ + (lane & 31); }
#pragma unroll
            for (int j_ = 0; j_ < 8; ++j_) tv[8 * par + j_] = twp[(size_t)(8 * par + j_) * NUP];
        }
        LAS unsigned char* Bc = L + cur * BUFB; LAS unsigned char* Stc = L + OST + cur * STB; LAS unsigned char* Stn = L + OST + (cur ^ 1) * STB;
        f32x4 acc0 = (f32x4){0.f, 0.f, 0.f, 0.f}, acc1 = acc0;
#pragma unroll
        for (int kk = 0; kk < 2; ++kk) { const bf16x8 a = *(const LAS bf16x8*)(Bc + OA + (16 * it + (lane & 15)) * 144 + (32 * kk + (lane >> 4) * 8) * 2);
            const bf16x8 v0 = *(const LAS bf16x8*)(Bc + OV + (32 * eh + (lane & 15)) * 144 + (32 * kk + (lane >> 4) * 8) * 2);
            const bf16x8 v1 = *(const LAS bf16x8*)(Bc + OV + (32 * eh + 16 + (lane & 15)) * 144 + (32 * kk + (lane >> 4) * 8) * 2);
            acc0 = MFMA16(v0, a, acc0); acc1 = MFMA16(v1, a, acc1); }
#pragma unroll
        for (int kk = 0; kk < 4; ++kk) { const bf16x8 a = *(const LAS bf16x8*)(Bc + OQ + (16 * it + (lane & 15)) * 272 + (32 * kk + (lane >> 4) * 8) * 2);
            const bf16x8 s0 = *(const LAS bf16x8*)(Stc + (32 * eh + (lane & 15)) * 272 + (32 * kk + (lane >> 4) * 8) * 2);
            const bf16x8 s1 = *(const LAS bf16x8*)(Stc + (32 * eh + 16 + (lane & 15)) * 272 + (32 * kk + (lane >> 4) * 8) * 2);
            acc0 = MFMA16(s0, a, acc0); acc1 = MFMA16(s1, a, acc1); }
        { const size_t tok = (size_t)b * T + n * 64 + 16 * it + (lane & 15); const int col = h * 256 + sl * 64 + 32 * eh + (lane >> 4) * 4;
          v2u w0, w1; w0.x = pk2(acc0[0], acc0[1]); w0.y = pk2(acc0[2], acc0[3]); w1.x = pk2(acc1[0], acc1[1]); w1.y = pk2(acc1[2], acc1[3]);
          __builtin_nontemporal_store(w0, (v2u*)(odir + tok * 1024 + col)); __builtin_nontemporal_store(w1, (v2u*)(odir + tok * 1024 + col + 16)); }
        { const f32x4 dsc = *(const LAS f32x4*)(Bc + ODV + (16 * w + (lane >> 4) * 4) * 4);
          bf16x8 ka[2];
#pragma unroll
          for (int kk = 0; kk < 2; ++kk) ka[kk] = *(const LAS bf16x8*)(Bc + OK_ + (16 * w + (lane & 15)) * 144 + (32 * kk + (lane >> 4) * 8) * 2);
#pragma unroll
          for (int e = 0; e < 4; ++e) { S[e] = S[e] * dsc;
#pragma unroll
              for (int kk = 0; kk < 2; ++kk) { const bf16x8 vf = *(const LAS bf16x8*)(Bc + OV + (16 * e + (lane & 15)) * 144 + (32 * kk + (lane >> 4) * 8) * 2); S[e] = MFMA16(ka[kk], vf, S[e]); }
              v2u p; p.x = pk2(S[e][0], S[e][1]); p.y = pk2(S[e][2], S[e][3]);
              *(LAS v2u*)(Stn + (16 * e + (lane & 15)) * 272 + (16 * w + (lane >> 4) * 4) * 2) = p; } }
        if (TCONV && par == 3) {
            if (tvalid) { bf16* d_ = Wt_up + (size_t)tdrow * D + tk0;
#pragma unroll
                for (int c_ = 0; c_ < 3; ++c_) { const f32x4 g0_ = *(const f32x4*)(kgain + tk0 + 8 * c_), g1_ = *(const f32x4*)(kgain + tk0 + 8 * c_ + 4); v4u o_;
                    o_.x = pk2(tv[8 * c_] * g0_[0], tv[8 * c_ + 1] * g0_[1]); o_.y = pk2(tv[8 * c_ + 2] * g0_[2], tv[8 * c_ + 3] * g0_[3]);
                    o_.z = pk2(tv[8 * c_ + 4] * g1_[0], tv[8 * c_ + 5] * g1_[1]); o_.w = pk2(tv[8 * c_ + 6] * g1_[2], tv[8 * c_ + 7] * g1_[3]);
                    *(v4u*)(d_ + 8 * c_) = o_; } }
            tl_valid = tvalid; tl_dst = Wt_up + (size_t)tdrow * D + tk0 + 24; tl_k = tk0 + 24;
#pragma unroll
            for (int j_ = 0; j_ < 8; ++j_) tl[j_] = tv[24 + j_];
        }
        if (step < 63) GS_STORE((par + 1) & 1, cur ^ 1);
        __syncthreads();
      }
    }
    if (TCONV && tl_valid) { const f32x4 g0_ = *(const f32x4*)(kgain + tl_k), g1_ = *(const f32x4*)(kgain + tl_k + 4); v4u o_;
        o_.x = pk2(tl[0] * g0_[0], tl[1] * g0_[1]); o_.y = pk2(tl[2] * g0_[2], tl[3] * g0_[3]); o_.z = pk2(tl[4] * g1_[0], tl[5] * g1_[1]); o_.w = pk2(tl[6] * g1_[2], tl[7] * g1_[3]);
        *(v4u*)tl_dst = o_; tl_valid = false; }
#undef GS_LOAD
#undef GS_STORE
}

__device__ __forceinline__ void attn_item(LAS unsigned char* L, int ai, const bf16* qa, const bf16* ka, const bf16* VTA, const float* sink, bf16* mix) {
    const int tid = threadIdx.x, lane = tid & 63, w = __builtin_amdgcn_readfirstlane(tid >> 6);
    const int qq = ai & 3, kvh = (ai >> 2) & 1, n = (ai >> 3) & 31, b = ai >> 8;
    const int g = w >> 1, hq = kvh * 4 + g, qrow0 = n * 128 + qq * 32 + (w & 1) * 16;
    LAS unsigned char* Ks = L; LAS unsigned char* Vs = L + 34816;
    bf16x8 qf[4];
#pragma unroll
    for (int kk = 0; kk < 4; ++kk) qf[kk] = __builtin_nontemporal_load((const bf16x8*)(qa + ((size_t)b * T + qrow0 + (lane & 15)) * 1024 + hq * 128 + 32 * kk + (lane >> 4) * 8));
    float mrun = sink[hq] * LOG2E, lsum = 1.f; f32x4 O[8];
#pragma unroll
    for (int dt = 0; dt < 8; ++dt) O[dt] = (f32x4){0.f, 0.f, 0.f, 0.f};
    const int kb_lo = n > 0 ? n - 1 : 0, kb_hi = n < 31 ? n + 1 : 31;
    v4u rk[4], rv[4];
#define AT_LOAD(kb_) do { _Pragma("unroll") for (int i_ = 0; i_ < 4; ++i_) { const int ch_ = tid + 512 * i_, r_ = ch_ >> 4, c_ = ch_ & 15; \
        rk[i_] = *(const v4u*)(ka + ((size_t)b * T + (kb_) * 128 + r_) * 256 + kvh * 128 + c_ * 8); \
        rv[i_] = *(const v4u*)(VTA + ((((size_t)b * 2 + kvh) * 32 + (kb_)) * 128 + r_) * 128 + c_ * 8); } } while (0)
    AT_LOAD(kb_lo);
    const int qpos = qrow0 + (lane & 15);
#pragma unroll 1
    for (int kb = kb_lo; kb <= kb_hi; ++kb) {
        __syncthreads();
#pragma unroll
        for (int i = 0; i < 4; ++i) { const int ch = tid + 512 * i, r = ch >> 4, c = ch & 15;
            *(LAS v4u*)(Ks + r * 272 + c * 16) = rk[i]; *(LAS v4u*)(Vs + r * 272 + c * 16) = rv[i]; }
        __syncthreads();
        if (kb < kb_hi) AT_LOAD(kb + 1);
#pragma unroll 1
        for (int kh = 0; kh < 2; ++kh) {
            const int kbase = kb * 128 + kh * 64;
            if (kbase + 63 < qrow0 - 128 || kbase > qrow0 + 15 + 128) continue;
            const LAS unsigned char* Kh = Ks + kh * (64 * 272); const LAS unsigned char* Vh = Vs + kh * 128;
            f32x4 s[4];
#pragma unroll
            for (int kt = 0; kt < 4; ++kt) { f32x4 acc = (f32x4){0.f, 0.f, 0.f, 0.f};
#pragma unroll
                for (int kk = 0; kk < 4; ++kk) { const bf16x8 kf = *(const LAS bf16x8*)(Kh + (16 * kt + (lane & 15)) * 272 + (32 * kk + (lane >> 4) * 8) * 2); acc = MFMA16(kf, qf[kk], acc); }
                s[kt] = acc; }
            float mx = -INFINITY;
#pragma unroll
            for (int kt = 0; kt < 4; ++kt)
#pragma unroll
                for (int jj = 0; jj < 4; ++jj) { const int dl = kbase + 16 * kt + (lane >> 4) * 4 + jj - qpos; if (dl > 128 || dl < -128) s[kt][jj] = -INFINITY; mx = fmaxf(mx, s[kt][jj]); }
            mx = fmaxf(mx, __shfl_xor(mx, 16)); mx = fmaxf(mx, __shfl_xor(mx, 32));
            const float mnew = fmaxf(mrun, mx), alpha = __builtin_amdgcn_exp2f(mrun - mnew);
            mrun = mnew;
            float rs = 0.f;
#pragma unroll
            for (int kt = 0; kt < 4; ++kt)
#pragma unroll
                for (int jj = 0; jj < 4; ++jj) { const float p = __builtin_amdgcn_exp2f(s[kt][jj] - mnew); s[kt][jj] = p; rs += p; }
            rs += __shfl_xor(rs, 16); rs += __shfl_xor(rs, 32);
            lsum = lsum * alpha + rs;
#pragma unroll
            for (int dt = 0; dt < 8; ++dt) O[dt] = O[dt] * alpha;
#pragma unroll
            for (int ks = 0; ks < 2; ++ks) {
                v4u pw; pw.x = pk2(s[2 * ks][0], s[2 * ks][1]); pw.y = pk2(s[2 * ks][2], s[2 * ks][3]); pw.z = pk2(s[2 * ks + 1][0], s[2 * ks + 1][1]); pw.w = pk2(s[2 * ks + 1][2], s[2 * ks + 1][3]);
                const bf16x8 pf = __builtin_bit_cast(bf16x8, pw);
#pragma unroll
                for (int dt = 0; dt < 8; ++dt) {
                    const LAS unsigned char* vp = Vh + (16 * dt + (lane & 15)) * 272 + (32 * ks + (lane >> 4) * 4) * 2;
                    const v2u v0 = *(const LAS v2u*)vp, v1 = *(const LAS v2u*)(vp + 32);
                    v4u vw; vw.x = v0.x; vw.y = v0.y; vw.z = v1.x; vw.w = v1.y;
                    O[dt] = MFMA16(__builtin_bit_cast(bf16x8, vw), pf, O[dt]);
                }
            }
        }
    }
#undef AT_LOAD
    { const float inv = 1.f / lsum;
      bf16* orow = mix + ((size_t)b * T + qrow0 + (lane & 15)) * 2048 + hq * 128 + (lane >> 4) * 4;
#pragma unroll
      for (int dt = 0; dt < 8; ++dt) { const f32x4 o = O[dt] * inv; v2u wv2; wv2.x = pk2(o[0], o[1]); wv2.y = pk2(o[2], o[3]); *(v2u*)(orow + 16 * dt) = wv2; } }
}

#define XB_TMO      128
#define XB_XCNT(j)  (256  + 64 * (j))
#define XB_XSUB(j)  (1280 + 64 * (j))
#define XB_XGEN(j)  (2304 + 64 * (j))
#define XB_TOP      3328
#define XB_TOPGEN   3392
#define XCD_BAR_WORDS 3456
#define XB_SPIN_CAP (1u << 22)
__device__ __forceinline__ unsigned xb_ld(unsigned* p)              { return __hip_atomic_load(p, __ATOMIC_RELAXED, __HIP_MEMORY_SCOPE_AGENT); }
__device__ __forceinline__ unsigned xb_add(unsigned* p, unsigned v) { return __hip_atomic_fetch_add(p, v, __ATOMIC_RELAXED, __HIP_MEMORY_SCOPE_AGENT); }
__device__ __forceinline__ unsigned xb_xcc_id() { return (unsigned)__builtin_amdgcn_s_getreg((3 << 11) | 20) & 0xFu; }
#define XB_SPIN(cond, bar) do { unsigned _sp = 0; while (cond) { __builtin_amdgcn_s_sleep(1); \
    if ((++_sp & 255u) == 0u) { if (xb_ld(&(bar)[XB_TMO])) break; if (_sp > XB_SPIN_CAP) { atomicAdd(&(bar)[XB_TMO], 1u); break; } } } } while (0)
struct XcdBarrier { unsigned* bar; unsigned x; volatile LAS unsigned* st; };
__device__ __forceinline__ XcdBarrier xcd_barrier_post(unsigned* bar, volatile LAS unsigned* st) {
    XcdBarrier b; b.bar = bar; b.x = xb_xcc_id(); b.st = st;
    if (threadIdx.x == 0) (void)xb_add(&bar[XB_XCNT(b.x)], 1u);
    return b;
}
__device__ __forceinline__ void xcd_barrier_complete(unsigned* bar, unsigned x, unsigned& nloc, unsigned& nx) {
    const unsigned G = gridDim.x * gridDim.y * gridDim.z;
    unsigned sum, cnt, mine, sp = 0u;
    for (;;) {
        sum = 0u; cnt = 0u; mine = 0u;
#pragma unroll
        for (unsigned j = 0; j < 16; ++j) { const unsigned c = xb_ld(&bar[XB_XCNT(j)]); sum += c; cnt += (c > 0u) ? 1u : 0u; mine = (j == x) ? c : mine; }
        if (sum == G) break;
        __builtin_amdgcn_s_sleep(1);
        if ((++sp & 255u) == 0u) { if (xb_ld(&bar[XB_TMO])) break; if (sp > XB_SPIN_CAP) { atomicAdd(&bar[XB_TMO], 1u); break; } }
    }
    nloc = mine > 0u ? mine : 1u; nx = cnt > 0u ? cnt : 1u;
}
__device__ __forceinline__ void xcd_barrier(const XcdBarrier& b) {
    asm volatile("s_waitcnt vmcnt(0)" ::: "memory");
    __syncthreads();
    if (threadIdx.x == 0) {
        unsigned* bar = b.bar;
        __builtin_amdgcn_s_waitcnt(0);
        unsigned nloc = b.st[0], nx = b.st[1];
        if (nloc == 0u) { xcd_barrier_complete(bar, b.x, nloc, nx); b.st[0] = nloc; b.st[1] = nx; }
        const unsigned old = xb_add(&bar[XB_XSUB(b.x)], 1u);
        const unsigned gen = old / nloc;
        if (old + 1u == (gen + 1u) * nloc) {
            __builtin_amdgcn_fence(__ATOMIC_RELEASE, "agent");
            asm volatile("s_waitcnt vmcnt(0)" ::: "memory");
            const unsigned og = xb_add(&bar[XB_TOP], 1u);
            const unsigned tg = og / nx;
            if (og + 1u == (tg + 1u) * nx) xb_add(&bar[XB_TOPGEN], 1u);
            else XB_SPIN(xb_ld(&bar[XB_TOPGEN]) == tg, bar);
            __builtin_amdgcn_fence(__ATOMIC_ACQUIRE, "agent");
            xb_add(&bar[XB_XGEN(b.x)], 1u);
            asm volatile("s_waitcnt vmcnt(0)" ::: "memory");
        } else {
            XB_SPIN(xb_ld(&bar[XB_XGEN(b.x)]) == gen, bar);
            __builtin_amdgcn_fence(__ATOMIC_ACQUIRE, "agent");
            asm volatile("s_waitcnt vmcnt(0)" ::: "memory");
        }
    }
    __syncthreads();
}

__global__ void __launch_bounds__(NTHR, 2) hymba_fwd(Args args) {
    extern __shared__ __attribute__((aligned(16))) unsigned char lds_raw[];
    LAS unsigned char* L = (LAS unsigned char*)lds_raw;
    cg::grid_group grid = cg::this_grid();
    const int tid = threadIdx.x, lane = tid & 63, wave = __builtin_amdgcn_readfirstlane(tid >> 6);
    const int G = gridDim.x, bx = blockIdx.x;
    const int gw = bx * NWAVES + wave, NGW = G * NWAVES;
#define KARG(i) (((volatile const __attribute__((address_space(4))) unsigned long long*)__builtin_amdgcn_kernarg_segment_ptr())[i])
#define GAS __attribute__((address_space(1)))
#define INP(i) ((const float*)(GAS const float*)KARG(i))
#define WSP(off) ((unsigned char*)((GAS unsigned char*)KARG(18) + (off)))
#define OUTP ((float*)(GAS float*)KARG(17))
    const int lo = args.ph_lo, hi = args.ph_hi;
#ifndef REPEAT_MASK
#define REPEAT_MASK 0
#endif
#ifndef PHASE_MASK
#define PHASE_MASK 0x1ff
#endif
#define IN(k) (((PHASE_MASK >> (k)) & 1) && lo <= (k) && (k) < hi)
#define SEAMX(k, k2) do { if (IN(k) && IN(k2)) xcd_barrier(xbar); } while (0)
#define SEAM(k) SEAMX(k, (k) + 1)
    if (tid < 64) ((LAS unsigned*)(L + LDS_XB))[tid] = 0u;
    __syncthreads();
    const XcdBarrier xbar = xcd_barrier_post((unsigned*)WSP(0), (volatile LAS unsigned*)(L + LDS_XB));

    if (lo < 0) grid.sync();
    if (IN(0)) for (int rep_ = 0; rep_ < 1 + ((REPEAT_MASK >> 0) & 1); ++rep_) { if (rep_) grid.sync();
        const float* x = INP(0); const float* norm1_g = INP(1); const float* w_in = INP(2); const float* w_out = INP(11); const float* w_up = INP(13); const float* w_down = INP(16); const float* norm2_g = INP(12);
        bf16* Wt_in = (bf16*)WSP(WS_WIN); bf16* Wt_out = (bf16*)WSP(WS_WOUT); bf16* Wt_up = (bf16*)WSP(WS_WUP); bf16* Wt_dn = (bf16*)WSP(WS_WDN); bf16* Hb = (bf16*)WSP(WS_H);
        LAS float* scr = (LAS float*)(L + wave * 16384);
        constexpr int I_IN = (D / 64) * (NPROJ / 32), I_UP = (D / 64) * (NUP / 32);
        const int NITEMS = I_IN + (G == 256 ? 0 : I_UP);
        for (int it = gw; it < NITEMS; it += NGW) {
            int r = it;
            if (r < I_IN) { transpose_item(w_in, D, NPROJ, Wt_in, 0, scr, r, lane); continue; } r -= I_IN;
            transpose_item(w_up, D, NUP, Wt_up, 1, scr, r, lane, norm2_g);
        }
        { v4u z = (v4u){0u, 0u, 0u, 0u}; v4u* p = (v4u*)(Wt_in + (size_t)NPROJ * D); const int nv = (NPROJ_P - NPROJ) * D / 8;
          for (int i = bx * NTHR + tid; i < nv; i += G * NTHR) p[i] = z; }
        for (int m = gw; m < M; m += 2 * NGW) {
            const int m2 = m + NGW;
            const f32x4* xa = (const f32x4*)(x + (size_t)m * D) + lane; const f32x4* xb = (const f32x4*)(x + (size_t)(m2 < M ? m2 : m) * D) + lane; const f32x4* gr = (const f32x4*)norm1_g + lane;
            f32x4 va[8], vb[8]; float sa = 0.f, sb = 0.f;
#pragma unroll
            for (int j = 0; j < 8; ++j) { va[j] = xa[64 * j]; vb[j] = xb[64 * j]; }
#pragma unroll
            for (int j = 0; j < 8; ++j) { sa += (va[j].x * va[j].x + va[j].y * va[j].y) + (va[j].z * va[j].z + va[j].w * va[j].w); sb += (vb[j].x * vb[j].x + vb[j].y * vb[j].y) + (vb[j].z * vb[j].z + vb[j].w * vb[j].w); }
            const float ra = __builtin_amdgcn_rsqf(wave_sum(sa) * (1.f / D) + EPS), rb = __builtin_amdgcn_rsqf(wave_sum(sb) * (1.f / D) + EPS);
            v2u* oa = (v2u*)(Hb + (size_t)m * D) + lane; v2u* ob2 = (v2u*)(Hb + (size_t)m2 * D) + lane;
#pragma unroll
            for (int j = 0; j < 8; ++j) { const f32x4 g = gr[64 * j];
                v2u w; w.x = pk2(va[j].x * ra * g.x, va[j].y * ra * g.y); w.y = pk2(va[j].z * ra * g.z, va[j].w * ra * g.w); oa[64 * j] = w;
                if (m2 < M) { v2u w2; w2.x = pk2(vb[j].x * rb * g.x, vb[j].y * rb * g.y); w2.y = pk2(vb[j].z * rb * g.z, vb[j].w * rb * g.w); ob2[64 * j] = w2; } }
        }
    }
    SEAM(0);
    if (IN(1)) for (int rep_ = 0; rep_ < 1 + ((REPEAT_MASK >> 1) & 1); ++rep_) { if (rep_) grid.sync();
        bf16* Wt_in = (bf16*)WSP(WS_WIN); bf16* Hb = (bf16*)WSP(WS_H); bf16* proj = (bf16*)WSP(WS_PROJ);
        pg8::Gemm g{Hb, Wt_in, M, NPROJ_P, D}; pg8::StaticOrder S; S.init(M, NPROJ_P, G, bx);
        pg8::EpiBf16 E{proj, NPROJ_P};
        pg8::gemm_phase<pg8::EpiBf16, pg8::StaticOrder, true, false>(L, g, S, E);
        { const int nwg = (M / 256) * (NPROJ_P / 256), full = nwg / G, rem = nwg - full * G;
          const float* w_out = INP(11); bf16* Wt_out = (bf16*)WSP(WS_WOUT); LAS float* scr = (LAS float*)(L + wave * 16384);
          constexpr int I_OUT = (D / 64) * (D / 32);
          if (rem > 0) { if (bx >= rem) {
              for (int it = (bx - rem) * NWAVES + wave; it < I_OUT; it += (G - rem) * NWAVES) transpose_item(w_out, D, D, Wt_out, 0, scr, it, lane);
              if (G == 256) {
                  const float* w_up = INP(13); const float* norm2_g = INP(12); bf16* Wt_up = (bf16*)WSP(WS_WUP);
                  for (int it = (bx - rem) * NWAVES + wave; it < W_UP_EARLY; it += (G - rem) * NWAVES) transpose_item(w_up, D, NUP, Wt_up, 1, scr, it, lane, norm2_g);
              } } }
          else for (int it = gw; it < I_OUT; it += NGW) transpose_item(w_out, D, D, Wt_out, 0, scr, it, lane);
        }
    }
    SEAM(1);
    if (IN(2)) for (int rep_ = 0; rep_ < 1 + ((REPEAT_MASK >> 2) & 1); ++rep_) { if (rep_) grid.sync();
        const float* qn_g = INP(3); const float* kn_g = INP(4); const float* wa2f = INP(6); const float* baf = INP(7); const float* wa2b = INP(8); const float* bab = INP(9);
        bf16* proj = (bf16*)WSP(WS_PROJ); bf16* qa = (bf16*)WSP(WS_QA); bf16* KOTb = (bf16*)WSP(WS_KOT); bf16* Abuf = (bf16*)WSP(WS_AB); bf16* QIb = (bf16*)WSP(WS_QI);
        float* DVb = (float*)WSP(WS_DV); bf16* VTG = (bf16*)WSP(WS_VTG); bf16* ka = (bf16*)WSP(WS_KA); bf16* VTA = (bf16*)WSP(WS_VTA);
        gla_prep_block(L, bx, G, proj, wa2f, baf, wa2b, bab, Abuf, QIb, KOTb, DVb);
        __syncthreads();
        {
            const float inv = exp2f(-(float)lane * (13.287712379549449f / 64.f));
            const float gq1 = qn_g[lane], gq2 = qn_g[lane + 64], gk1 = kn_g[lane], gk2 = kn_g[lane + 64];
            unsigned short r1[10], r2[10], n1[10], n2[10];
            if (gw < M) { const bf16* prow = proj + (size_t)gw * NPROJ_P;
#pragma unroll
                for (int hd = 0; hd < 10; ++hd) { r1[hd] = prow[hd * 128 + lane]; r2[hd] = prow[hd * 128 + 64 + lane]; } }
            for (int tok = gw; tok < M; tok += NGW) {
                { const int tn = tok + NGW < M ? tok + NGW : tok; const bf16* prow = proj + (size_t)tn * NPROJ_P;
#pragma unroll
                  for (int hd = 0; hd < 10; ++hd) { n1[hd] = prow[hd * 128 + lane]; n2[hd] = prow[hd * 128 + 64 + lane]; } }
                const int t = tok & (T - 1);
                const float ang = (float)t * inv;
                double rev = (double)ang * 0.15915494309189535; rev -= rint(rev);
                const float fr = (float)rev;
                const float sn = __builtin_amdgcn_sinf(fr), cs = __builtin_amdgcn_cosf(fr);
#pragma unroll
                for (int hd = 0; hd < 10; ++hd) {
                    const int c0 = hd * 128;
                    const float x1 = bf2f(r1[hd]), x2 = bf2f(r2[hd]);
                    const float r = __builtin_amdgcn_rsqf(wave_sum(x1 * x1 + x2 * x2) * (1.f / 128.f) + EPS);
                    const float y1 = x1 * r * (hd < 8 ? gq1 : gk1), y2 = x2 * r * (hd < 8 ? gq2 : gk2);
                    float o1 = y1 * cs - y2 * sn, o2 = y2 * cs + y1 * sn;
                    if (hd < 8) { o1 *= QSCALE; o2 *= QSCALE; bf16* q = qa + (size_t)tok * 1024 + c0; q[lane] = (bf16)f2bf(o1); q[lane + 64] = (bf16)f2bf(o2); }
                    else { bf16* k = ka + (size_t)tok * 256 + (hd - 8) * 128; k[lane] = (bf16)f2bf(o1); k[lane + 64] = (bf16)f2bf(o2); }
                }
#pragma unroll
                for (int hd = 0; hd < 10; ++hd) { r1[hd] = n1[hd]; r2[hd] = n2[hd]; }
            }
        }
        {
            LAS unsigned char* tl = L + wave * 9216;
            for (int ti = gw; ti < 256 * 20; ti += NGW) {
                const int rt = ti / 20, ct = ti % 20, tok0 = rt * 64;
                const int srccol = ct < 4 ? C_VA + ct * 64 : C_VG + (ct - 4) * 64;
#pragma unroll
                for (int i = 0; i < 8; ++i) { const int r = (lane >> 3) + 8 * i, c8 = lane & 7;
                    *(LAS v4u*)(tl + r * 144 + c8 * 16) = __builtin_nontemporal_load((const v4u*)(proj + (size_t)(tok0 + r) * NPROJ_P + srccol + c8 * 8)); }
                LDS_WAIT(); asm volatile("" ::: "memory");
                const int bb = tok0 / T, tpos = tok0 % T;
#pragma unroll
                for (int i = 0; i < 8; ++i) {
                    const int o = lane + 64 * i, cidx = o >> 3, tg = o & 7;
                    unsigned short v[8];
#pragma unroll
                    for (int jj = 0; jj < 8; ++jj) v[jj] = *(const LAS unsigned short*)(tl + (tg * 8 + jj) * 144 + cidx * 2);
                    v4u ov; ov.x = v[0] | ((unsigned)v[1] << 16); ov.y = v[2] | ((unsigned)v[3] << 16); ov.z = v[4] | ((unsigned)v[5] << 16); ov.w = v[6] | ((unsigned)v[7] << 16);
                    if (ct < 4) { const int kb = tpos >> 7, koff = tpos & 127, kvh = ct >> 1, d = (ct & 1) * 64 + cidx;
                        *(v4u*)(VTA + ((((size_t)bb * 2 + kvh) * 32 + kb) * 128 + d) * 128 + koff + tg * 8) = ov; }
                    else { const int cgi = ct - 4, h = cgi >> 2, e = (cgi & 3) * 64 + cidx, n = tpos >> 6;
                        *(v4u*)(VTG + ((((size_t)bb * 4 + h) * 64 + n) * 256 + e) * 64 + tg * 8) = ov; }
                }
                LDS_WAIT(); asm volatile("" ::: "memory");
            }
        }
    }
    SEAM(2);
    if (IN(3)) for (int rep_ = 0; rep_ < 1 + ((REPEAT_MASK >> 3) & 1); ++rep_) { if (rep_) grid.sync();
        const float* sink = INP(5); bf16* of = (bf16*)OUTP; bf16* ob = of + (size_t)M * 1024;
        bf16* qa = (bf16*)WSP(WS_QA); bf16* KOTb = (bf16*)WSP(WS_KOT); bf16* Abuf = (bf16*)WSP(WS_AB); bf16* QIb = (bf16*)WSP(WS_QI); bf16* mix = (bf16*)WSP(WS_MIX);
        float* DVb = (float*)WSP(WS_DV); bf16* VTG = (bf16*)WSP(WS_VTG); bf16* ka = (bf16*)WSP(WS_KA); bf16* VTA = (bf16*)WSP(WS_VTA);
        if (G == 256) {
            const int xq = bx & 7, j = bx >> 3;
            if (j < 16) gla_scan_item<false>(L, xq * 16 + j, Abuf, QIb, KOTb, DVb, VTG, of, ob, nullptr, nullptr, nullptr, -1, 1);
            else {
                const int aidx = xq * 16 + (j - 16);
                for (int ai = aidx; ai < 1024; ai += 128) attn_item(L, ai, qa, ka, VTA, sink, mix);
                __syncthreads();
                { const float* w_up = INP(13); const float* norm2_g = INP(12); bf16* Wt_up = (bf16*)WSP(WS_WUP); LAS float* scr = (LAS float*)(L + wave * 16384);
                  constexpr int I_UP = (D / 64) * (NUP / 32);
                  for (int it = W_UP_EARLY + aidx * NWAVES + wave; it < I_UP; it += 128 * NWAVES) transpose_item(w_up, D, NUP, Wt_up, 1, scr, it, lane, norm2_g); }
            }
        } else {
            for (int wi = bx; wi < 128; wi += G) gla_scan_item<false>(L, wi, Abuf, QIb, KOTb, DVb, VTG, of, ob, nullptr, nullptr, nullptr, -1, 1);
            for (int ai = bx; ai < 1024; ai += G) attn_item(L, ai, qa, ka, VTA, sink, mix);
        }
    }
    SEAM(3);
    if (IN(4)) for (int rep_ = 0; rep_ < 1 + ((REPEAT_MASK >> 4) & 1); ++rep_) { if (rep_) grid.sync();
        const float* gon_g = INP(10); const bf16* of = (const bf16*)OUTP; const bf16* ob = of + (size_t)M * 1024; bf16* proj = (bf16*)WSP(WS_PROJ); bf16* mix = (bf16*)WSP(WS_MIX);
        for (int it0 = gw; it0 < M * 4; it0 += 4 * NGW) {
            v2u a[4], c[4], gt[4]; size_t o[4]; int tk[4], hh[4];
#pragma unroll
            for (int u = 0; u < 4; ++u) { const int it = it0 + u * NGW < M * 4 ? it0 + u * NGW : it0; tk[u] = it >> 2; hh[u] = it & 3;
                o[u] = (size_t)tk[u] * 1024 + hh[u] * 256 + lane * 4;
                a[u] = __builtin_nontemporal_load((const v2u*)(of + o[u])); c[u] = __builtin_nontemporal_load((const v2u*)(ob + o[u])); gt[u] = __builtin_nontemporal_load((const v2u*)(proj + (size_t)tk[u] * NPROJ_P + C_GG + hh[u] * 256 + lane * 4)); }
            const f32x4 gn = *(const f32x4*)(gon_g + lane * 4);
#pragma unroll
            for (int u = 0; u < 4; ++u) {
                if (u > 0 && it0 + u * NGW >= M * 4) break;
                const f32x4 v = (f32x4){bflo(a[u].x) + bflo(c[u].x), bfhi(a[u].x) + bfhi(c[u].x), bflo(a[u].y) + bflo(c[u].y), bfhi(a[u].y) + bfhi(c[u].y)};
                const float r = __builtin_amdgcn_rsqf(wave_sum((v.x * v.x + v.y * v.y) + (v.z * v.z + v.w * v.w)) * (1.f / 256.f) + EPS);
                float gv[4] = {bflo(gt[u].x), bfhi(gt[u].x), bflo(gt[u].y), bfhi(gt[u].y)}, y[4];
#pragma unroll
                for (int k = 0; k < 4; ++k) { const float sg = gv[k] * __builtin_amdgcn_rcpf(1.f + __expf(-gv[k])); y[k] = v[k] * r * gn[k] * sg; }
                v2u wv2; wv2.x = pk2(y[0], y[1]); wv2.y = pk2(y[2], y[3]);
                *(v2u*)(mix + (size_t)tk[u] * 2048 + 1024 + hh[u] * 256 + lane * 4) = wv2;
            }
        }
    }
    SEAM(4);
    if (IN(5)) for (int rep_ = 0; rep_ < 1 + ((REPEAT_MASK >> 5) & 1); ++rep_) { if (rep_) grid.sync();
        const float* x = INP(0); float* out = OUTP; bf16* mix = (bf16*)WSP(WS_MIX); bf16* Wt_out = (bf16*)WSP(WS_WOUT); bf16* H2 = (bf16*)WSP(WS_H2); float* rowss = (float*)WSP(WS_RSS);
        for (int p = gw; p < H2ROWS; p += NGW) { const int b = p / PB, q = p - b * PB;
            if (b >= 4 || q < 1 || q > T) { v2u z; z.x = 0u; z.y = 0u; v2u* o8 = (v2u*)(H2 + (size_t)p * D) + lane;
#pragma unroll
                for (int j = 0; j < 8; ++j) o8[64 * j] = z; } }
        pg8::Gemm g{mix, Wt_out, M, D, D}; pg8::StaticOrder S; S.init(M, D, G, bx);
        pg8::EpiX1 E{x, H2, rowss, D};
        pg8::gemm_phase<pg8::EpiX1, pg8::StaticOrder, true, false>(L, g, S, E);
    }
    SEAMX(5, 7);
    if (IN(7)) for (int rep_ = 0; rep_ < 1 + ((REPEAT_MASK >> 7) & 1); ++rep_) { if (rep_) grid.sync();
        const float* conv_w = INP(14); const float* conv_b = INP(15); bf16* H2 = (bf16*)WSP(WS_H2); bf16* Wt_up = (bf16*)WSP(WS_WUP); bf16* act = (bf16*)WSP(WS_ACT); const float* rowss = (const float*)WSP(WS_RSS);
        pg8::Gemm g{H2, Wt_up, 67 * 256, NUP, D}; pg8::StaticOrder S; S.init(67 * 256, NUP, G, bx);
        pg8::EpiConv E{act, conv_w, conv_b, rowss};
        pg8::gemm_phase<pg8::EpiConv, pg8::StaticOrder, true, true>(L, g, S, E);
        { const int nwg = 67 * (NUP / 256), full = nwg / G, rem = nwg - full * G;
          const float* w_down = INP(16); bf16* Wt_dn = (bf16*)WSP(WS_WDN); LAS float* scr = (LAS float*)(L + wave * 16384);
          constexpr int I_DN = (DFF / 64) * (D / 32);
          if (rem > 0) { if (bx >= rem) for (int it = (bx - rem) * NWAVES + wave; it < I_DN; it += (G - rem) * NWAVES) transpose_item(w_down, DFF, D, Wt_dn, 0, scr, it, lane); }
          else for (int it = gw; it < I_DN; it += NGW) transpose_item(w_down, DFF, D, Wt_dn, 0, scr, it, lane);
        }
    }
    SEAM(7);
    if (IN(8)) for (int rep_ = 0; rep_ < 1 + ((REPEAT_MASK >> 8) & 1); ++rep_) { if (rep_) grid.sync();
        float* out = OUTP; bf16* act = (bf16*)WSP(WS_ACT); bf16* Wt_dn = (bf16*)WSP(WS_WDN);
        pg8::Gemm g{act, Wt_dn, M, D, DFF}; pg8::StaticOrder S; S.init(M, D, G, bx);
        pg8::EpiOut E{out, (const bf16*)WSP(WS_H2), D};
        pg8::gemm_phase<pg8::EpiOut, pg8::StaticOrder, true, false>(L, g, S, E);
    }
#undef IN
#undef SEAM
}

#ifndef MK_N_LAUNCHES
#define MK_N_LAUNCHES 1
#endif

extern "C" void kernel_launch(void* const* d_in, const int* in_sizes, int n_in, void* d_out, int out_size, void* d_ws, size_t ws_size, hipStream_t stream) {
    static int grid = 0;
    if (grid == 0) {
        if (n_in != 17 || out_size != M * D || ws_size < WS_END) { fprintf(stderr, "kernel_launch: unexpected shapes (n_in %d out %d ws %zu)\n", n_in, out_size, ws_size); grid = -1; return; }
        int dev = 0, cus = 0, per_cu = 0;
        hipGetDevice(&dev);
        hipDeviceGetAttribute(&cus, hipDeviceAttributeMultiprocessorCount, dev);
        if (hipFuncSetAttribute((const void*)hymba_fwd, hipFuncAttributeMaxDynamicSharedMemorySize, LDS_BYTES) != hipSuccess) { fprintf(stderr, "kernel_launch: hipFuncSetAttribute failed\n"); grid = -1; return; }
        if (hipOccupancyMaxActiveBlocksPerMultiprocessor(&per_cu, (const void*)hymba_fwd, NTHR, LDS_BYTES) != hipSuccess || per_cu < 1) { fprintf(stderr, "kernel_launch: occupancy query says %d\n", per_cu); per_cu = 1; }
        (void)hipGetLastError();
        if (per_cu > 1) per_cu = 1;
        grid = cus * per_cu;
        if (grid > 256) grid = 256;
    }
    if (grid < 0) return;
    if (hipMemsetAsync(d_ws, 0, 131072, stream) != hipSuccess) { fprintf(stderr, "kernel_launch: memset failed\n"); return; }
    Args a{};
    for (int i = 0; i < 17; ++i) a.in[i] = (const float*)d_in[i];
    a.out = (float*)d_out; a.ws = (unsigned char*)d_ws;
#if MK_N_LAUNCHES == 1
    a.ph_lo = 0; a.ph_hi = 9;
    void* kargs[] = {&a};
    hipError_t e = hipLaunchCooperativeKernel((const void*)hymba_fwd, dim3(grid), dim3(NTHR), kargs, LDS_BYTES, stream);
    if (e != hipSuccess) fprintf(stderr, "cooperative launch failed: %s (grid %d)\n", hipGetErrorString(e), grid);
#else
    for (int p = 0; p < 9; ++p) { a.ph_lo = p; a.ph_hi = p + 1; hipLaunchKernelGGL(hymba_fwd, dim3(grid), dim3(NTHR), LDS_BYTES, stream, a); }
#endif
}
```

```cpp
#include <hip/hip_runtime.h>
#include <hip/hip_cooperative_groups.h>
#include <cstdio>
#include <cstdint>
namespace cg = cooperative_groups;

#define LAS __attribute__((address_space(3)))
typedef unsigned short bf16;
typedef unsigned v4u __attribute__((ext_vector_type(4)));
typedef unsigned v2u __attribute__((ext_vector_type(2)));
typedef float f32x4 __attribute__((ext_vector_type(4)));
typedef short bf16x8 __attribute__((ext_vector_type(8)));
typedef short s16x4 __attribute__((ext_vector_type(4)));

namespace pg8 {
#define PG8_LAS __attribute__((address_space(3)))
typedef unsigned short bf16_t;
constexpr int BM = 256, BK = 64, HALF = 128, HTB = HALF * BK * 2, STAGE_BYTES = 8 * HTB, NXCD = 8, WGM = 8;

__host__ __device__ __forceinline__ int lds_byte(int r, int c) { const int st = (r >> 4) * 2 + (c >> 5), rr = r & 15, cc = c & 31, ob = rr * 64 + cc * 2; return st * 1024 + (ob ^ (((ob >> 9) & 1) << 5)); }
__host__ __device__ __forceinline__ void stage_rc(int b, int& R, int& C) { const int st = b / 1024, sb = b % 1024, swz = sb ^ (((sb >> 9) & 1) << 5); R = (st >> 1) * 16 + swz / 64; C = (st & 1) * 32 + (swz % 64) / 2; }
__host__ __device__ __forceinline__ int perm32(int rho) { const int n = rho >> 4, i = rho & 15; return 8 * (i >> 2) + 4 * n + (i & 3); }

struct Unit { int pm, pn; };
struct Gemm { const bf16_t* A; const bf16_t* Bt; int M, N, K; };

struct StaticOrder {
    int nM, nN, nwg, G, c;
    __host__ __device__ void init(int M, int N, int G_, int c_) { nM = M / BM; nN = N / BM; nwg = nM * nN; G = G_; c = c_; }
    __host__ __device__ bool next(int i, Unit& u) const {
        const long L = (long)i * G + c; if (L >= nwg) return false;
        int wgid = (int)L; { const int q = nwg / NXCD, r = nwg % NXCD, xcd = wgid % NXCD, off = wgid / NXCD; wgid = (xcd < r ? xcd * (q + 1) : r * (q + 1) + (xcd - r) * q) + off; }
        const int nig = WGM * nN, gid = wgid / nig, fm = gid * WGM, gsz = (nM - fm) < WGM ? (nM - fm) : WGM;
        u.pm = fm + ((wgid % nig) % gsz); u.pn = (wgid % nig) / gsz; return true;
    }
    __device__ __forceinline__ void a_ready(const Unit&) const {}
    __device__ __forceinline__ void done(const Unit&) const {}
};

__device__ __forceinline__ unsigned cvt_pk_bf16(float lo, float hi) { unsigned r; asm volatile("v_cvt_pk_bf16_f32 %0, %1, %2" : "=v"(r) : "v"(lo), "v"(hi)); return r; }

struct EpiBf16 {
    static constexpr bool PERM = true, AFTER_DRAIN = false;
    bf16_t* O; int ldc;
    __device__ __forceinline__ void operator()(const f32x4 (&acc)[2][2][4][2], const Unit& u, int wr, int wc, int fr, int fq) const {
        const int row0 = u.pm * BM + wr * 64 + fr; const int col0 = u.pn * BM + wc * 32 + 8 * fq;
#pragma unroll
        for (int ai = 0; ai < 2; ++ai)
#pragma unroll
            for (int m = 0; m < 4; ++m) { bf16_t* rowp = O + (size_t)(row0 + ai * HALF + m * 16) * ldc + col0;
#pragma unroll
                for (int bj = 0; bj < 2; ++bj) { const f32x4 v0 = acc[ai][bj][m][0], v1 = acc[ai][bj][m][1];
                    v4u w; w.x = cvt_pk_bf16(v0[0], v0[1]); w.y = cvt_pk_bf16(v0[2], v0[3]); w.z = cvt_pk_bf16(v1[0], v1[1]); w.w = cvt_pk_bf16(v1[2], v1[3]);
                    *(v4u*)(rowp + bj * HALF) = w; } }
    }
};
struct EpiResF32 {
    static constexpr bool PERM = true, AFTER_DRAIN = false;
    float* C; const float* R; int ldc;
    __device__ __forceinline__ void operator()(const f32x4 (&acc)[2][2][4][2], const Unit& u, int wr, int wc, int fr, int fq) const {
        const int row0 = u.pm * BM + wr * 64 + fr, col0 = u.pn * BM + wc * 32 + 8 * fq;
#pragma unroll
        for (int ai = 0; ai < 2; ++ai)
#pragma unroll
            for (int m = 0; m < 4; ++m) { const size_t ro = (size_t)(row0 + ai * HALF + m * 16) * ldc + col0;
#pragma unroll
                for (int bj = 0; bj < 2; ++bj)
#pragma unroll
                    for (int n = 0; n < 2; ++n) { const f32x4 r = *(const f32x4*)(R + ro + bj * HALF + n * 4); *(f32x4*)(C + ro + bj * HALF + n * 4) = acc[ai][bj][m][n] + r; } }
    }
};
struct EpiX1 {
    static constexpr bool PERM = true, AFTER_DRAIN = false;
    const float* R; bf16_t* H2; float* rowss; int ldc;
    __device__ __forceinline__ void operator()(const f32x4 (&acc)[2][2][4][2], const Unit& u, int wr, int wc, int fr, int fq) const {
        const int row0 = u.pm * BM + wr * 64 + fr, col0 = u.pn * BM + wc * 32 + 8 * fq;
#pragma unroll
        for (int ai = 0; ai < 2; ++ai)
#pragma unroll
            for (int m = 0; m < 4; ++m) { const int row = row0 + ai * HALF + m * 16; const size_t ro = (size_t)row * ldc + col0;
                const size_t po = (size_t)((row >> 12) * 4154 + 1 + (row & 4095)) * ldc + col0;
                float ss = 0.f;
#pragma unroll
                for (int bj = 0; bj < 2; ++bj) {
                    const f32x4 r0 = __builtin_nontemporal_load((const f32x4*)(R + ro + bj * HALF)), r1 = __builtin_nontemporal_load((const f32x4*)(R + ro + bj * HALF + 4));
                    const f32x4 v0 = acc[ai][bj][m][0] + r0, v1 = acc[ai][bj][m][1] + r1;
                    v4u w; w.x = cvt_pk_bf16(v0[0], v0[1]); w.y = cvt_pk_bf16(v0[2], v0[3]); w.z = cvt_pk_bf16(v1[0], v1[1]); w.w = cvt_pk_bf16(v1[2], v1[3]);
                    *(v4u*)(H2 + po + bj * HALF) = w;
                    ss += (v0[0] * v0[0] + v0[1] * v0[1]) + (v0[2] * v0[2] + v0[3] * v0[3]) + (v1[0] * v1[0] + v1[1] * v1[1]) + (v1[2] * v1[2] + v1[3] * v1[3]); }
                ss += __shfl_xor(ss, 16); ss += __shfl_xor(ss, 32);
                if (fq == 0) atomicAdd(rowss + row, ss);
            }
    }
};
struct EpiOut {
    static constexpr bool PERM = true, AFTER_DRAIN = false;
    float* C; const bf16_t* H2; int ldc;
    __device__ __forceinline__ void operator()(const f32x4 (&acc)[2][2][4][2], const Unit& u, int wr, int wc, int fr, int fq) const {
        const int row0 = u.pm * BM + wr * 64 + fr, col0 = u.pn * BM + wc * 32 + 8 * fq;
#pragma unroll
        for (int ai = 0; ai < 2; ++ai)
#pragma unroll
            for (int m = 0; m < 4; ++m) { const int row = row0 + ai * HALF + m * 16; const size_t ro = (size_t)row * ldc + col0;
                const size_t po = (size_t)((row >> 12) * 4154 + 1 + (row & 4095)) * ldc + col0;
#pragma unroll
                for (int bj = 0; bj < 2; ++bj) {
                    const v4u h = __builtin_nontemporal_load((const v4u*)(H2 + po + bj * HALF));
                    const f32x4 r0 = (f32x4){__builtin_bit_cast(float, h.x << 16), __builtin_bit_cast(float, h.x & 0xffff0000u), __builtin_bit_cast(float, h.y << 16), __builtin_bit_cast(float, h.y & 0xffff0000u)};
                    const f32x4 r1 = (f32x4){__builtin_bit_cast(float, h.z << 16), __builtin_bit_cast(float, h.z & 0xffff0000u), __builtin_bit_cast(float, h.w << 16), __builtin_bit_cast(float, h.w & 0xffff0000u)};
                    __builtin_nontemporal_store(acc[ai][bj][m][0] + r0, (f32x4*)(C + ro + bj * HALF)); __builtin_nontemporal_store(acc[ai][bj][m][1] + r1, (f32x4*)(C + ro + bj * HALF + 4)); }
            }
    }
};
__device__ __forceinline__ float dpp_f(float oldv, float src, int) { return src + oldv; }
template <int CTRL> __device__ __forceinline__ float dppmov(float oldv, float src) {
    return __builtin_bit_cast(float, __builtin_amdgcn_update_dpp(__builtin_bit_cast(int, oldv), __builtin_bit_cast(int, src), CTRL, 0xf, 0xf, false));
}
template <int CTRL> __device__ __forceinline__ float rormov(float src) {
    return __builtin_bit_cast(float, __builtin_amdgcn_mov_dpp(__builtin_bit_cast(int, src), CTRL, 0xf, 0xf, true));
}
struct EpiConv {
    static constexpr bool PERM = true, AFTER_DRAIN = false;
    bf16_t* act; const float* cw; const float* cb; const float* rowss;
    __device__ __forceinline__ void operator()(const f32x4 (&acc_in)[2][2][4][2], const Unit& u, int wr, int wc, int fr, int fq) const {
        constexpr int NU = 11264, FF = 5632, PB = 4154;
        const int gc0 = u.pn * 128 + wc * 32 + fq * 8;
        f32x4 acc[2][2][4][2];
#pragma unroll
        for (int ai = 0; ai < 2; ++ai)
#pragma unroll
            for (int m = 0; m < 4; ++m) {
                const int p = 62 * (4 * u.pm + 2 * ai + wr) + 16 * m + fr, b = p / PB, q = p - b * PB;
                float rr = 0.f;
                if (q >= 1 && q <= 4096 && b < 4) rr = __builtin_amdgcn_rsqf(rowss[b * 4096 + q - 1] * (1.f / 2048.f) + 1e-6f);
#pragma unroll
                for (int bj = 0; bj < 2; ++bj)
#pragma unroll
                    for (int n = 0; n < 2; ++n) acc[ai][bj][m][n] = acc_in[ai][bj][m][n] * rr;
            }
        unsigned half0[2][4][2];
#pragma unroll
        for (int n = 0; n < 2; ++n) {
            const int gc = gc0 + 4 * n;
            const f32x4 wg0 = *(const f32x4*)(cw + gc), wg1 = *(const f32x4*)(cw + NU + gc), wg2 = *(const f32x4*)(cw + 2 * NU + gc), bg = *(const f32x4*)(cb + gc);
            const f32x4 wv0 = *(const f32x4*)(cw + FF + gc), wv1 = *(const f32x4*)(cw + NU + FF + gc), wv2 = *(const f32x4*)(cw + 2 * NU + FF + gc), bv = *(const f32x4*)(cb + FF + gc);
#pragma unroll
            for (int ai = 0; ai < 2; ++ai) {
                const int slab = 4 * u.pm + 2 * ai + wr, p0 = 62 * slab;
#pragma unroll
                for (int m = 0; m < 4; ++m) {
                    float o[4];
#pragma unroll
                    for (int x = 0; x < 4; ++x) {
                        const float gcur = acc[ai][0][m][n][x], vcur = acc[ai][1][m][n][x];
                        const float gtp = (m > 0 && fr == 15) ? acc[ai][0][m - 1][n][x] : gcur, vtp = (m > 0 && fr == 15) ? acc[ai][1][m - 1][n][x] : vcur;
                        const float gtn = (m < 3 && fr == 0) ? acc[ai][0][m + 1][n][x] : gcur, vtn = (m < 3 && fr == 0) ? acc[ai][1][m + 1][n][x] : vcur;
                        const float gp = rormov<0x121>(gtp), gn = rormov<0x12F>(gtn);
                        const float vp = rormov<0x121>(vtp), vn = rormov<0x12F>(vtn);
                        const float Gv = wg0[x] * gp + wg1[x] * gcur + wg2[x] * gn + bg[x];
                        const float Vv = wv0[x] * vp + wv1[x] * vcur + wv2[x] * vn + bv[x];
                        const float sg = Gv * __builtin_amdgcn_rcpf(1.f + __builtin_amdgcn_exp2f(-1.4426950408889634f * Gv));
                        o[x] = sg * Vv;
                    }
                    if (n == 0) { half0[ai][m][0] = cvt_pk_bf16(o[0], o[1]); half0[ai][m][1] = cvt_pk_bf16(o[2], o[3]); }
                    else {
                        const int rs = 16 * m + fr, p = p0 + rs, b = p / PB, q = p - b * PB;
                        if (rs >= 1 && rs <= 62 && q >= 1 && q <= 4096 && b < 4) {
                            v4u w; w.x = half0[ai][m][0]; w.y = half0[ai][m][1]; w.z = cvt_pk_bf16(o[0], o[1]); w.w = cvt_pk_bf16(o[2], o[3]);
                            __builtin_nontemporal_store(w, (v4u*)(act + (size_t)(b * 4096 + q - 1) * FF + gc0));
                        }
                    }
                }
            }
        }
    }
};

template <class Epi, class Sched, bool ALIGN_EPI, bool SLAB>
__device__ __forceinline__ void gemm_phase(PG8_LAS unsigned char* lds, const Gemm g, const Sched& S, const Epi& E) {
    const int tid = threadIdx.x, wid = __builtin_amdgcn_readfirstlane(tid >> 6), lane = tid & 63, wr = wid >> 2, wc = wid & 3, fr = lane & 15, fq = lane >> 4;
    const int K = g.K, nt = K / BK;
    unsigned voffA[2], voffB[2];
#pragma unroll
    for (int i = 0; i < 2; ++i) { int R, C; stage_rc(tid * 16 + i * 8192, R, C); const int Rb = Epi::PERM ? ((R & ~31) + perm32(R & 31)) : R;
        const int Ra = SLAB ? (R - 2 * (R >> 6)) : R;
        voffA[i] = (unsigned)(Ra * K + C) * 2u; voffB[i] = (unsigned)(Rb * K + C) * 2u; }
    const size_t kstep = (size_t)(BK * 2);
    const size_t hstepB = (size_t)HALF * K * 2, tstepB = 2 * hstepB;
    const size_t hstepA = SLAB ? (size_t)124 * K * 2 : hstepB, tstepA = 2 * hstepA;
    const unsigned ldsw = (unsigned)wid * 1024u;
    const int aoff = lds_byte(wr * 64 + fr, fq * 8), boff = lds_byte(wc * 32 + fr, fq * 8);
#define PG8_SA(b, h) (((b) * 2 + (h)) * HTB)
#define PG8_SB(b, h) ((4 + (b) * 2 + (h)) * HTB)
#define PG8_STAGE(bufoff, gbase, voff) do { _Pragma("unroll") for (int _i = 0; _i < 2; ++_i) \
        __builtin_amdgcn_global_load_lds((const unsigned*)((const char*)(gbase) + (voff)[_i]), (PG8_LAS unsigned*)(lds + (bufoff) + ldsw + _i * 8192), 16, 0, 0); } while (0)
#define PG8_LDA(dst, b, h) do { _Pragma("unroll") for (int m = 0; m < 4; ++m) _Pragma("unroll") for (int k = 0; k < 2; ++k) dst[m][k] = *(const PG8_LAS bf16x8*)(lds + PG8_SA(b, h) + aoff + m * 2048 + k * 1024); } while (0)
#define PG8_LDB(dst, b, h) do { _Pragma("unroll") for (int n = 0; n < 2; ++n) _Pragma("unroll") for (int k = 0; k < 2; ++k) dst[n][k] = *(const PG8_LAS bf16x8*)(lds + PG8_SB(b, h) + boff + n * 2048 + k * 1024); } while (0)
#define PG8_MMA(ai, bj, At, Bt) do { __builtin_amdgcn_s_setprio(1); _Pragma("unroll") for (int m = 0; m < 4; ++m) _Pragma("unroll") for (int n = 0; n < 2; ++n) _Pragma("unroll") for (int k = 0; k < 2; ++k) \
        acc[ai][bj][m][n] = __builtin_amdgcn_mfma_f32_16x16x32_bf16(Bt[n][k], At[m][k], acc[ai][bj][m][n], 0, 0, 0); __builtin_amdgcn_s_setprio(0); } while (0)
#define PG8_WAIT_V(n) asm volatile("s_waitcnt vmcnt(" #n ")" ::: "memory")
#define PG8_WAIT_L(n) asm volatile("s_waitcnt lgkmcnt(" #n ")" ::: "memory")
#define PG8_BAR __builtin_amdgcn_s_barrier()
#define PG8_SCHED __builtin_amdgcn_sched_barrier(0)
    Unit cur, nxt; int ui = 0;
    if (!S.next(0, cur)) return;
    f32x4 acc[2][2][4][2];
#pragma unroll
    for (int a = 0; a < 2; ++a)
#pragma unroll
        for (int b = 0; b < 2; ++b)
#pragma unroll
            for (int m = 0; m < 4; ++m)
#pragma unroll
                for (int n = 0; n < 2; ++n) acc[a][b][m][n] = (f32x4){0.f, 0.f, 0.f, 0.f};
    bf16x8 At[4][2], B0[2][2], B1[2][2];
    const char* cA = (const char*)g.A + (size_t)cur.pm * tstepA; const char* cB = (const char*)g.Bt + (size_t)cur.pn * tstepB;
    S.a_ready(cur);
    PG8_STAGE(PG8_SB(0, 0), cB, voffB); PG8_STAGE(PG8_SB(0, 1), cB + hstepB, voffB); PG8_STAGE(PG8_SA(0, 0), cA, voffA); PG8_STAGE(PG8_SA(0, 1), cA + hstepA, voffA);
    if (wr == 1) PG8_BAR;
    PG8_WAIT_V(2); PG8_BAR;
    PG8_STAGE(PG8_SB(1, 0), cB + kstep, voffB); PG8_STAGE(PG8_SA(1, 0), cA + kstep, voffA); PG8_STAGE(PG8_SB(1, 1), cB + hstepB + kstep, voffB);
    PG8_WAIT_V(6); PG8_BAR;
    for (;;) {
        const bool has_next = S.next(ui + 1, nxt);
        const char* nA = has_next ? (const char*)g.A + (size_t)nxt.pm * tstepA : cA; const char* nB = has_next ? (const char*)g.Bt + (size_t)nxt.pn * tstepB : cB;
        for (int t = 0; t < nt; t += 2) {
            const bool last = (t == nt - 2);
            const char* a1 = cA + (size_t)(t + 1) * kstep;
            const char* a2 = last ? nA : cA + (size_t)(t + 2) * kstep; const char* b2 = last ? nB : cB + (size_t)(t + 2) * kstep;
            const char* a3 = a2 + kstep; const char* b3 = b2 + kstep;
            if (last && has_next) S.a_ready(nxt);
            PG8_LDB(B0, 0, 0); PG8_LDB(B1, 0, 1); PG8_SCHED; PG8_LDA(At, 0, 0); PG8_STAGE(PG8_SA(1, 1), a1 + hstepA, voffA);
            PG8_WAIT_V(8); PG8_WAIT_L(0); PG8_BAR; PG8_MMA(0, 0, At, B0); PG8_MMA(0, 1, At, B1); PG8_BAR; PG8_SCHED;
            PG8_LDA(At, 0, 1); PG8_STAGE(PG8_SB(0, 0), b2, voffB); PG8_STAGE(PG8_SB(0, 1), b2 + hstepB, voffB); PG8_STAGE(PG8_SA(0, 0), a2, voffA);
            PG8_WAIT_V(8); PG8_WAIT_L(0); PG8_BAR; PG8_MMA(1, 0, At, B0); PG8_MMA(1, 1, At, B1); PG8_BAR; PG8_SCHED;
            PG8_LDB(B0, 1, 0); PG8_LDB(B1, 1, 1); PG8_SCHED; PG8_LDA(At, 1, 0); PG8_STAGE(PG8_SA(0, 1), a2 + hstepA, voffA);
            PG8_WAIT_V(8); PG8_WAIT_L(0); PG8_BAR; PG8_MMA(0, 0, At, B0); PG8_MMA(0, 1, At, B1); PG8_BAR; PG8_SCHED;
            PG8_LDA(At, 1, 1); PG8_STAGE(PG8_SB(1, 0), b3, voffB); PG8_STAGE(PG8_SB(1, 1), b3 + hstepB, voffB); PG8_STAGE(PG8_SA(1, 0), a3, voffA);
            PG8_WAIT_V(8); PG8_WAIT_L(0); PG8_BAR; PG8_MMA(1, 0, At, B0); PG8_MMA(1, 1, At, B1); PG8_BAR; PG8_SCHED;
        }
        if constexpr (ALIGN_EPI) { if (wr == 0) PG8_BAR; }
        E(acc, cur, wr, wc, fr, fq); S.done(cur);
        if (!has_next) break;
#pragma unroll
        for (int a = 0; a < 2; ++a)
#pragma unroll
            for (int b = 0; b < 2; ++b)
#pragma unroll
                for (int m = 0; m < 4; ++m)
#pragma unroll
                    for (int n = 0; n < 2; ++n) acc[a][b][m][n] = (f32x4){0.f, 0.f, 0.f, 0.f};
        cur = nxt; cA = nA; cB = nB; ++ui;
        if constexpr (ALIGN_EPI) { if (wr == 1) PG8_BAR; }
    }
    PG8_WAIT_V(0);
    if constexpr (!ALIGN_EPI) { if (wr == 0) PG8_BAR; }
    PG8_BAR;
#undef PG8_SA
#undef PG8_SB
#undef PG8_STAGE
#undef PG8_LDA
#undef PG8_LDB
#undef PG8_MMA
#undef PG8_WAIT_V
#undef PG8_WAIT_L
#undef PG8_BAR
#undef PG8_SCHED
}
}

constexpr int NWAVES = 8, NTHR = 512;
constexpr int BATCH = 4, T = 4096, D = 2048, M = BATCH * T;
constexpr int NPROJ = 4640, NPROJ_P = 4864;
constexpr int DFF = 5632, NUP = 11264;
constexpr int C_QA = 0, C_KA = 1024, C_VA = 1280, C_QG = 1536, C_KG = 2048, C_VG = 2560, C_GG = 3584, C_LRF = 4608;
constexpr int PB = 4154, H2ROWS = 67 * 248 + 2;
constexpr float EPS = 1e-6f;
constexpr float LOG2E = 1.4426950408889634f;
constexpr float QSCALE = 0.08838834764831845f * LOG2E;
constexpr float GLA_SC = 0.08838834764831845f;

constexpr size_t MiB = 1u << 20;
constexpr size_t WS_RSS = 65536;
constexpr size_t WS_WIN = 1 * MiB, WS_WOUT = 20 * MiB, WS_WUP = 28 * MiB, WS_WDN = 72 * MiB;
constexpr size_t WS_H = 96 * MiB;
constexpr size_t WS_QA = 96 * MiB, WS_KOT = 128 * MiB;
constexpr size_t WS_PROJ = 160 * MiB;
constexpr size_t WS_MIX = 312 * MiB;
constexpr size_t WS_AB = 376 * MiB, WS_QI = 392 * MiB, WS_DV = 424 * MiB, WS_VTG = 426 * MiB, WS_KA = 458 * MiB, WS_VTA = 466 * MiB, WS_END = 474 * MiB;
constexpr size_t WS_H2 = 160 * MiB;
constexpr size_t WS_ACT = 232 * MiB;
static_assert(WS_H2 + (size_t)H2ROWS * D * 2 <= WS_ACT && WS_ACT + (size_t)M * DFF * 2 <= WS_END, "ws map");

constexpr int LDS_BYTES = 147456;
constexpr int LDS_XB = LDS_BYTES - 1024;
constexpr int W_UP_EARLY = 3072;

typedef float f32x2_t __attribute__((ext_vector_type(2)));
typedef __bf16 bf16x2_t __attribute__((ext_vector_type(2)));
__device__ __forceinline__ unsigned pk2(float lo, float hi) { f32x2_t v = {lo, hi}; bf16x2_t b = __builtin_convertvector(v, bf16x2_t); return __builtin_bit_cast(unsigned, b); }
__device__ __forceinline__ unsigned f2bf(float f) { return pk2(f, 0.f) & 0xffffu; }
__device__ __forceinline__ float bflo(unsigned w) { return __builtin_bit_cast(float, w << 16); }
__device__ __forceinline__ float bfhi(unsigned w) { return __builtin_bit_cast(float, w & 0xffff0000u); }
__device__ __forceinline__ float bf2f(unsigned short b) { return __builtin_bit_cast(float, (unsigned)b << 16); }
__device__ __forceinline__ float wave_sum(float v) {
#pragma unroll
    for (int o = 1; o < 64; o <<= 1) v += __shfl_xor(v, o);
    return v;
}
#define LDS_WAIT() asm volatile("s_waitcnt lgkmcnt(0)" ::: "memory")
#define MFMA16(a, b, c) __builtin_amdgcn_mfma_f32_16x16x32_bf16((a), (b), (c), 0, 0, 0)

struct Args {
    const float* in[17]; float* out; unsigned char* ws; int ph_lo, ph_hi;
};

__device__ __forceinline__ void transpose_item(const float* W, int K, int N, bf16* WT, int mode, LAS float* scr, int item, int lane, const float* kgain = nullptr) {
    const int nblk = N / 32, kb = item / nblk, nb = item % nblk, k0 = 64 * kb, n0 = 32 * nb;
    int drow0 = n0;
    if (mode == 1) drow0 = (n0 < DFF) ? (n0 / 128) * 256 + (n0 % 128) : ((n0 - DFF) / 128) * 256 + 128 + ((n0 - DFF) % 128);
    float tv[32];
#pragma unroll
    for (int i = 0; i < 32; ++i) { const int kk = 2 * i + (lane >> 5); tv[i] = __builtin_nontemporal_load(W + (size_t)(k0 + kk) * N + n0 + (lane & 31)); }
    if (kgain) {
#pragma unroll
        for (int i = 0; i < 32; ++i) tv[i] *= kgain[k0 + 2 * i + (lane >> 5)];
    }
#pragma unroll
    for (int i = 0; i < 32; ++i) { const int kk = 2 * i + (lane >> 5); scr[kk * 33 + (lane & 31)] = tv[i]; }
    LDS_WAIT(); asm volatile("" ::: "memory");
    const int c = lane & 7;
#pragma unroll
    for (int j = 0; j < 4; ++j) { const int n = (lane >> 3) + 8 * j; const LAS float* s = scr + (8 * c) * 33 + n;
        v4u o; o.x = pk2(s[0 * 33], s[1 * 33]); o.y = pk2(s[2 * 33], s[3 * 33]); o.z = pk2(s[4 * 33], s[5 * 33]); o.w = pk2(s[6 * 33], s[7 * 33]);
        *(v4u*)(WT + (size_t)(drow0 + n) * K + k0 + 8 * c) = o; }
    LDS_WAIT(); asm volatile("" ::: "memory");
}
__device__ __forceinline__ void rms_row_to_bf16(const float* xrow, const float* gain, bf16* orow, int lane) {
    const f32x4* xr = (const f32x4*)xrow + lane; const f32x4* gr = (const f32x4*)gain + lane;
    f32x4 v[8]; float s = 0.f;
#pragma unroll
    for (int j = 0; j < 8; ++j) { v[j] = __builtin_nontemporal_load(xr + 64 * j); s += (v[j].x * v[j].x + v[j].y * v[j].y) + (v[j].z * v[j].z + v[j].w * v[j].w); }
    const float r = 1.0f / sqrtf(wave_sum(s) * (1.f / D) + EPS);
    v2u* o8 = (v2u*)orow + lane;
#pragma unroll
    for (int j = 0; j < 8; ++j) { const f32x4 g = gr[64 * j]; v2u w; w.x = pk2(v[j].x * r * g.x, v[j].y * r * g.y); w.y = pk2(v[j].z * r * g.z, v[j].w * r * g.w); o8[64 * j] = w; }
}

__device__ __forceinline__ void gla_prep_block(LAS unsigned char* L, int item0, int istride, const bf16* proj, const float* wa2f, const float* baf, const float* wa2b, const float* bab,
                                              bf16* Abuf, bf16* QIb, bf16* KOTb, float* DVb) {
    const int tid = threadIdx.x, lane = tid & 63, w = __builtin_amdgcn_readfirstlane(tid >> 6);
    LAS unsigned char* Qs = L; LAS unsigned char* Ks = L + 17408; LAS unsigned char* Gs = L + 34816; LAS float* Tot = (LAS float*)(L + 68608);
    LAS float* LRs = (LAS float*)(L + 70656); LAS unsigned char* QEs = L + 78848; LAS unsigned char* KEs = L + 96256; LAS unsigned char* KOs = L + 113664;
    v4u pq[2], pk[2]; v2u plr;
    bf16x8 wBf = (bf16x8){0, 0, 0, 0, 0, 0, 0, 0}, wBb = wBf; float biasf = 0.f, biasb = 0.f; int hprev = -1;
#define GP_LOAD(it_) do { const int b_ = (it_) >> 8, h_ = ((it_) >> 6) & 3, n_ = (it_) & 63, tk_ = b_ * T + n_ * 64; \
        _Pragma("unroll") for (int i_ = 0; i_ < 2; ++i_) { const int ch_ = tid + 512 * i_, r_ = ch_ >> 4, c_ = ch_ & 15; \
            pq[i_] = __builtin_nontemporal_load((const v4u*)(proj + (size_t)(tk_ + r_) * NPROJ_P + C_QG + h_ * 128 + c_ * 8)); \
            pk[i_] = __builtin_nontemporal_load((const v4u*)(proj + (size_t)(tk_ + r_) * NPROJ_P + C_KG + h_ * 128 + c_ * 8)); } \
        { const int idx_ = tid * 4, dir_ = idx_ >> 10, r_ = (idx_ >> 4) & 63, c_ = idx_ & 15; \
          plr = *(const v2u*)(proj + (size_t)(tk_ + r_) * NPROJ_P + C_LRF + dir_ * 16 + c_); } } while (0)
    if (item0 < 1024) GP_LOAD(item0);
#pragma unroll 1
  for (int item = item0; item < 1024; item += istride) {
    const int b = item >> 8, h = (item >> 6) & 3, n = item & 63;
    if (h != hprev) { hprev = h; const int d = h * 128 + 16 * w + (lane & 15), lg = lane >> 4;
        if (lg < 2) { float a[8], c[8];
#pragma unroll
            for (int j = 0; j < 8; ++j) { a[j] = wa2f[(lg * 8 + j) * 512 + d]; c[j] = wa2b[(lg * 8 + j) * 512 + d]; }
            v4u pa, pc; pa.x = pk2(a[0], a[1]); pa.y = pk2(a[2], a[3]); pa.z = pk2(a[4], a[5]); pa.w = pk2(a[6], a[7]);
            pc.x = pk2(c[0], c[1]); pc.y = pk2(c[2], c[3]); pc.z = pk2(c[4], c[5]); pc.w = pk2(c[6], c[7]);
            wBf = __builtin_bit_cast(bf16x8, pa); wBb = __builtin_bit_cast(bf16x8, pc); }
        biasf = baf[d]; biasb = bab[d]; }
    __syncthreads();
#pragma unroll
    for (int i = 0; i < 2; ++i) { const int ch = tid + 512 * i, r = ch >> 4, c = ch & 15;
        *(LAS v4u*)(Qs + r * 272 + c * 16) = pq[i]; *(LAS v4u*)(Ks + r * 272 + c * 16) = pk[i]; }
    { const int idx = tid * 4, dir = idx >> 10, r = (idx >> 4) & 63, c = idx & 15;
      *(LAS v2u*)((LAS unsigned char*)LRs + (dir * 64 + r) * 32 + c * 2) = plr; }
    if (item + istride < 1024) GP_LOAD(item + istride);
    __syncthreads();
#pragma unroll 1
    for (int dir = 0; dir < 2; ++dir) {
        const int ci = (((b * 4 + h) * 2 + dir) * 64 + n);
        {
            const int dl = lane & 15, lg = lane >> 4;
            const float bias = dir ? biasb : biasf;
            float g[4][4];
#pragma unroll
            for (int tt = 0; tt < 4; ++tt) {
                bf16x8 a = (bf16x8){0, 0, 0, 0, 0, 0, 0, 0};
                if (lg < 2) a = *(const LAS bf16x8*)((LAS unsigned char*)LRs + (dir * 64 + 16 * tt + dl) * 32 + lg * 16);
                const f32x4 z4 = MFMA16(a, dir ? wBb : wBf, ((f32x4){0.f, 0.f, 0.f, 0.f}));
#pragma unroll
                for (int jj = 0; jj < 4; ++jj) { const float z = z4[jj] + bias; g[tt][jj] = (fminf(z, 0.f) - __logf(1.f + __expf(-fabsf(z)))) * (1.f / 16.f); }
            }
            float carry = 0.f;
#pragma unroll
            for (int k = 0; k < 4; ++k) {
                const int tt = dir ? 3 - k : k;
                float p[4];
                if (dir == 0) { p[0] = g[tt][0]; p[1] = p[0] + g[tt][1]; p[2] = p[1] + g[tt][2]; p[3] = p[2] + g[tt][3]; }
                else { p[3] = g[tt][3]; p[2] = p[3] + g[tt][2]; p[1] = p[2] + g[tt][1]; p[0] = p[1] + g[tt][0]; }
                const float gt = dir ? p[0] : p[3];
                const float t0 = __shfl(gt, dl), t1 = __shfl(gt, dl + 16), t2 = __shfl(gt, dl + 32), t3 = __shfl(gt, dl + 48);
                float excl;
                if (dir == 0) excl = (lg > 0 ? t0 : 0.f) + (lg > 1 ? t1 : 0.f) + (lg > 2 ? t2 : 0.f);
                else excl = (lg < 3 ? t3 : 0.f) + (lg < 2 ? t2 : 0.f) + (lg < 1 ? t1 : 0.f);
                const float base = carry + excl;
#pragma unroll
                for (int jj = 0; jj < 4; ++jj) *(LAS float*)(Gs + (16 * tt + 4 * lg + jj) * 528 + (16 * w + dl) * 4) = base + p[jj];
                carry += (t0 + t1) + (t2 + t3);
            }
            __syncthreads();
        }
        {
            const int t = tid >> 3, d0 = (tid & 7) * 16;
            const int tref = dir ? 31 : 32, tlast = dir ? 0 : 63;
#pragma unroll
            for (int hf = 0; hf < 2; ++hf) {
                const int dd = d0 + 8 * hf;
                const v4u q8 = *(const LAS v4u*)(Qs + t * 272 + dd * 2), k8 = *(const LAS v4u*)(Ks + t * 272 + dd * 2);
                float qv[8], kv[8], cc[8], cr[8], cl[8];
                qv[0] = bflo(q8.x); qv[1] = bfhi(q8.x); qv[2] = bflo(q8.y); qv[3] = bfhi(q8.y); qv[4] = bflo(q8.z); qv[5] = bfhi(q8.z); qv[6] = bflo(q8.w); qv[7] = bfhi(q8.w);
                kv[0] = bflo(k8.x); kv[1] = bfhi(k8.x); kv[2] = bflo(k8.y); kv[3] = bfhi(k8.y); kv[4] = bflo(k8.z); kv[5] = bfhi(k8.z); kv[6] = bflo(k8.w); kv[7] = bfhi(k8.w);
#pragma unroll
                for (int x4 = 0; x4 < 2; ++x4) {
                    const f32x4 a = *(const LAS f32x4*)(Gs + t * 528 + (dd + 4 * x4) * 4), r4 = *(const LAS f32x4*)(Gs + tref * 528 + (dd + 4 * x4) * 4), l4 = *(const LAS f32x4*)(Gs + tlast * 528 + (dd + 4 * x4) * 4);
#pragma unroll
                    for (int x = 0; x < 4; ++x) { cc[4 * x4 + x] = a[x]; cr[4 * x4 + x] = r4[x]; cl[4 * x4 + x] = l4[x]; }
                }
                float qe[8], ke[8], qi[8], ko[8];
#pragma unroll
                for (int x = 0; x < 8; ++x) { const float qq = qv[x] * GLA_SC;
                    qe[x] = qq * __expf(cc[x] - cr[x]); ke[x] = kv[x] * __expf(cr[x] - cc[x]); qi[x] = qq * __expf(cc[x]); ko[x] = kv[x] * __expf(cl[x] - cc[x]); }
                v4u o;
                o.x = pk2(qe[0], qe[1]); o.y = pk2(qe[2], qe[3]); o.z = pk2(qe[4], qe[5]); o.w = pk2(qe[6], qe[7]); *(LAS v4u*)(QEs + t * 272 + dd * 2) = o;
                o.x = pk2(ke[0], ke[1]); o.y = pk2(ke[2], ke[3]); o.z = pk2(ke[4], ke[5]); o.w = pk2(ke[6], ke[7]); *(LAS v4u*)(KEs + t * 272 + dd * 2) = o;
                o.x = pk2(ko[0], ko[1]); o.y = pk2(ko[2], ko[3]); o.z = pk2(ko[4], ko[5]); o.w = pk2(ko[6], ko[7]); *(LAS v4u*)(KOs + t * 272 + dd * 2) = o;
                o.x = pk2(qi[0], qi[1]); o.y = pk2(qi[2], qi[3]); o.z = pk2(qi[4], qi[5]); o.w = pk2(qi[6], qi[7]); *(v4u*)(QIb + ((size_t)ci * 64 + t) * 128 + dd) = o;
            }
            if (tid < 128) DVb[(size_t)ci * 128 + tid] = __expf(*(const LAS float*)(Gs + tlast * 528 + tid * 4));
            __syncthreads();
        }
        {
            const int d = tid >> 2, tq = tid & 3;
            unsigned short v[16];
#pragma unroll
            for (int i = 0; i < 16; ++i) v[i] = *(const LAS unsigned short*)(KOs + (tq * 16 + i) * 272 + d * 2);
            v4u o0, o1;
            o0.x = v[0] | ((unsigned)v[1] << 16); o0.y = v[2] | ((unsigned)v[3] << 16); o0.z = v[4] | ((unsigned)v[5] << 16); o0.w = v[6] | ((unsigned)v[7] << 16);
            o1.x = v[8] | ((unsigned)v[9] << 16); o1.y = v[10] | ((unsigned)v[11] << 16); o1.z = v[12] | ((unsigned)v[13] << 16); o1.w = v[14] | ((unsigned)v[15] << 16);
            bf16* dst = KOTb + ((size_t)ci * 128 + d) * 64 + tq * 16;
            *(v4u*)dst = o0; *(v4u*)(dst + 8) = o1;
        }
        {
#pragma unroll
            for (int tt = 0; tt < 2; ++tt) {
                const int tile = 2 * w + tt, jt = tile >> 2, it = tile & 3;
                f32x4 acc = (f32x4){0.f, 0.f, 0.f, 0.f};
#pragma unroll
                for (int kk = 0; kk < 4; ++kk) {
                    const bf16x8 a = *(const LAS bf16x8*)(KEs + (16 * jt + (lane & 15)) * 272 + (32 * kk + (lane >> 4) * 8) * 2);
                    const bf16x8 bq = *(const LAS bf16x8*)(QEs + (16 * it + (lane & 15)) * 272 + (32 * kk + (lane >> 4) * 8) * 2);
                    acc = MFMA16(a, bq, acc);
                }
                const int i = 16 * it + (lane & 15), jb = 16 * jt + (lane >> 4) * 4;
                float o[4];
#pragma unroll
                for (int jj = 0; jj < 4; ++jj) { const int j = jb + jj; const bool keep = dir ? (j > i) : (j <= i); o[jj] = keep ? acc[jj] : 0.f; }
                v2u wv2; wv2.x = pk2(o[0], o[1]); wv2.y = pk2(o[2], o[3]);
                *(v2u*)(Abuf + ((size_t)ci * 64 + i) * 64 + jb) = wv2;
            }
        }
        __syncthreads();
    }
  }
#undef GP_LOAD
}

template <bool TCONV> __device__ __forceinline__ void gla_scan_item(LAS unsigned char* L, int wi, const bf16* Abuf, const bf16* QIb, const bf16* KOTb, const float* DVb, const bf16* VTG, bf16* of, bf16* ob,
                                              const float* w_up, const float* kgain, bf16* Wt_up, int tgw, int tngw) {
    const int tid = threadIdx.x, lane = tid & 63, w = __builtin_amdgcn_readfirstlane(tid >> 6);
    const int chain = wi >> 2, sl = wi & 3, dir = chain & 1, bh = chain >> 1, b = bh >> 2, h = bh & 3;
    bf16* odir = dir ? ob : of;
    constexpr int BUFB = 54784, OA = 0, OQ = 9216, OK_ = 26624, OV = 45056, ODV = 54272, OST = 2 * BUFB, STB = 17408;
    v4u rA[2], rQ[2][2], rK[2][2], rV[2]; float rD[2];
#define GS_LOAD(s_, nn) do { const size_t ci_ = (size_t)chain * 64 + (nn); \
        rA[s_] = *(const v4u*)(Abuf + (ci_ * 64 + (tid >> 3)) * 64 + (tid & 7) * 8); \
        _Pragma("unroll") for (int i_ = 0; i_ < 2; ++i_) { const int ch_ = tid + 512 * i_; \
            rQ[s_][i_] = *(const v4u*)(QIb + (ci_ * 64 + (ch_ >> 4)) * 128 + (ch_ & 15) * 8); \
            rK[s_][i_] = *(const v4u*)(KOTb + (ci_ * 128 + (ch_ >> 3)) * 64 + (ch_ & 7) * 8); } \
        rV[s_] = *(const v4u*)(VTG + (((size_t)bh * 64 + (nn)) * 256 + sl * 64 + (tid >> 3)) * 64 + (tid & 7) * 8); \
        rD[s_] = DVb[ci_ * 128 + (tid & 127)]; } while (0)
#define GS_STORE(s_, bi) do { LAS unsigned char* B_ = L + (bi) * BUFB; \
        *(LAS v4u*)(B_ + OA + (tid >> 3) * 144 + (tid & 7) * 16) = rA[s_]; \
        _Pragma("unroll") for (int i_ = 0; i_ < 2; ++i_) { const int ch_ = tid + 512 * i_; \
            *(LAS v4u*)(B_ + OQ + (ch_ >> 4) * 272 + (ch_ & 15) * 16) = rQ[s_][i_]; \
            *(LAS v4u*)(B_ + OK_ + (ch_ >> 3) * 144 + (ch_ & 7) * 16) = rK[s_][i_]; } \
        *(LAS v4u*)(B_ + OV + (tid >> 3) * 144 + (tid & 7) * 16) = rV[s_]; \
        if (tid < 128) *(LAS float*)(B_ + ODV + tid * 4) = rD[s_]; } while (0)
    __syncthreads();
    for (int i = tid; i < STB / 4; i += NTHR) ((LAS unsigned*)(L + OST))[i] = 0u;
    f32x4 S[4];
#pragma unroll
    for (int e = 0; e < 4; ++e) S[e] = (f32x4){0.f, 0.f, 0.f, 0.f};
    { const int n0 = dir ? 63 : 0; GS_LOAD(0, n0); GS_STORE(0, 0); const int n1 = dir ? 62 : 1; GS_LOAD(1, n1); }
    __syncthreads();
    const int it = w >> 1, eh = w & 1;
    constexpr int I_UPC = (D / 64) * (NUP / 32);
    float tv[32], tl[8]; int tk0 = 0, tdrow = 0, tl_k = 0; bool tvalid = false, tl_valid = false; const float* twp = w_up; bf16* tl_dst = Wt_up;
#pragma unroll 1
    for (int step4 = 0; step4 < 16; ++step4) {
#pragma unroll
      for (int par = 0; par < 4; ++par) {
        const int step = 4 * step4 + par, cur = par & 1;
        if (TCONV && par == 0 && tl_valid) { const f32x4 g0_ = *(const f32x4*)(kgain + tl_k), g1_ = *(const f32x4*)(kgain + tl_k + 4); v4u o_;
            o_.x = pk2(tl[0] * g0_[0], tl[1] * g0_[1]); o_.y = pk2(tl[2] * g0_[2], tl[3] * g0_[3]); o_.z = pk2(tl[4] * g1_[0], tl[5] * g1_[1]); o_.w = pk2(tl[6] * g1_[2], tl[7] * g1_[3]);
            *(v4u*)tl_dst = o_; tl_valid = false; }
        const int n = dir ? 63 - step : step;
        { const int nn = dir ? (n >= 2 ? n - 2 : 0) : (n <= 61 ? n + 2 : 63); GS_LOAD(par & 1, nn); }
        if constexpr (TCONV) {
            if (par == 0) { int it_ = tgw + step4 * tngw; tvalid = tgw >= 0 && it_ < I_UPC; it_ = tvalid ? it_ : I_UPC - 1;
                const int kb_ = it_ / (NUP / 32), nb_ = it_ - kb_ * (NUP / 32); tk0 = 64 * kb_ + 32 * (lane >> 5); const int n0_ = 32 * nb_;
                tdrow = ((n0_ < DFF) ? (n0_ / 128) * 256 + (n0_ % 128) : ((n0_ - DFF) / 128) * 256 + 128 + ((n0_ - DFF) % 128)) + (lane & 31);
                twp = w_up + (size_t)tk0 * NUP + n0_ + (lane & 31); }
#pragma unroll
            for (int j_ = 0; j_ < 8; ++j_) tv[8 * par + j_] = twp[(size_t)(8 * par + j_) * NUP];
        }
        LAS unsigned char* Bc = L + cur * BUFB; LAS unsigned char* Stc = L + OST + cur * STB; LAS unsigned char* Stn = L + OST + (cur ^ 1) * STB;
        f32x4 acc0 = (f32x4){0.f, 0.f, 0.f, 0.f}, acc1 = acc0;
#pragma unroll
        for (int kk = 0; kk < 2; ++kk) { const bf16x8 a = *(const LAS bf16x8*)(Bc + OA + (16 * it + (lane & 15)) * 144 + (32 * kk + (lane >> 4) * 8) * 2);
            const bf16x8 v0 = *(const LAS bf16x8*)(Bc + OV + (32 * eh + (lane & 15)) * 144 + (32 * kk + (lane >> 4) * 8) * 2);
            const bf16x8 v1 = *(const LAS bf16x8*)(Bc + OV + (32 * eh + 16 + (lane & 15)) * 144 + (32 * kk + (lane >> 4) * 8) * 2);
            acc0 = MFMA16(v0, a, acc0); acc1 = MFMA16(v1, a, acc1); }
#pragma unroll
        for (int kk = 0; kk < 4; ++kk) { const bf16x8 a = *(const LAS bf16x8*)(Bc + OQ + (16 * it + (lane & 15)) * 272 + (32 * kk + (lane >> 4) * 8) * 2);
            const bf16x8 s0 = *(const LAS bf16x8*)(Stc + (32 * eh + (lane & 15)) * 272 + (32 * kk + (lane >> 4) * 8) * 2);
            const bf16x8 s1 = *(const LAS bf16x8*)(Stc + (32 * eh + 16 + (lane & 15)) * 272 + (32 * kk + (lane >> 4) * 8) * 2);
            acc0 = MFMA16(s0, a, acc0); acc1 = MFMA16(s1, a, acc1); }
        { const size_t tok = (size_t)b * T + n * 64 + 16 * it + (lane & 15); const int col = h * 256 + sl * 64 + 32 * eh + (lane >> 4) * 4;
          v2u w0, w1; w0.x = pk2(acc0[0], acc0[1]); w0.y = pk2(acc0[2], acc0[3]); w1.x = pk2(acc1[0], acc1[1]); w1.y = pk2(acc1[2], acc1[3]);
          *(v2u*)(odir + tok * 1024 + col) = w0; *(v2u*)(odir + tok * 1024 + col + 16) = w1; }
        { const f32x4 dsc = *(const LAS f32x4*)(Bc + ODV + (16 * w + (lane >> 4) * 4) * 4);
          bf16x8 ka[2];
#pragma unroll
          for (int kk = 0; kk < 2; ++kk) ka[kk] = *(const LAS bf16x8*)(Bc + OK_ + (16 * w + (lane & 15)) * 144 + (32 * kk + (lane >> 4) * 8) * 2);
#pragma unroll
          for (int e = 0; e < 4; ++e) { S[e] = S[e] * dsc;
#pragma unroll
              for (int kk = 0; kk < 2; ++kk) { const bf16x8 vf = *(const LAS bf16x8*)(Bc + OV + (16 * e + (lane & 15)) * 144 + (32 * kk + (lane >> 4) * 8) * 2); S[e] = MFMA16(ka[kk], vf, S[e]); }
              v2u p; p.x = pk2(S[e][0], S[e][1]); p.y = pk2(S[e][2], S[e][3]);
              *(LAS v2u*)(Stn + (16 * e + (lane & 15)) * 272 + (16 * w + (lane >> 4) * 4) * 2) = p; } }
        if (TCONV && par == 3) {
            if (tvalid) { bf16* d_ = Wt_up + (size_t)tdrow * D + tk0;
#pragma unroll
                for (int c_ = 0; c_ < 3; ++c_) { const f32x4 g0_ = *(const f32x4*)(kgain + tk0 + 8 * c_), g1_ = *(const f32x4*)(kgain + tk0 + 8 * c_ + 4); v4u o_;
                    o_.x = pk2(tv[8 * c_] * g0_[0], tv[8 * c_ + 1] * g0_[1]); o_.y = pk2(tv[8 * c_ + 2] * g0_[2], tv[8 * c_ + 3] * g0_[3]);
                    o_.z = pk2(tv[8 * c_ + 4] * g1_[0], tv[8 * c_ + 5] * g1_[1]); o_.w = pk2(tv[8 * c_ + 6] * g1_[2], tv[8 * c_ + 7] * g1_[3]);
                    *(v4u*)(d_ + 8 * c_) = o_; } }
            tl_valid = tvalid; tl_dst = Wt_up + (size_t)tdrow * D + tk0 + 24; tl_k = tk0 + 24;
#pragma unroll
            for (int j_ = 0; j_ < 8; ++j_) tl[j_] = tv[24 + j_];
        }
        if (step < 63) GS_STORE((par + 1) & 1, cur ^ 1);
        __syncthreads();
      }
    }
    if (TCONV && tl_valid) { const f32x4 g0_ = *(const f32x4*)(kgain + tl_k), g1_ = *(const f32x4*)(kgain + tl_k + 4); v4u o_;
        o_.x = pk2(tl[0] * g0_[0], tl[1] * g0_[1]); o_.y = pk2(tl[2] * g0_[2], tl[3] * g0_[3]); o_.z = pk2(tl[4] * g1_[0], tl[5] * g1_[1]); o_.w = pk2(tl[6] * g1_[2], tl[7] * g1_[3]);
        *(v4u*)tl_dst = o_; tl_valid = false; }
#undef GS_LOAD
#undef GS_STORE
}

__device__ __forceinline__ void attn_item(LAS unsigned char* L, int ai, const bf16* qa, const bf16* ka, const bf16* VTA, const float* sink, bf16* mix) {
    const int tid = threadIdx.x, lane = tid & 63, w = __builtin_amdgcn_readfirstlane(tid >> 6);
    const int qq = ai & 3, kvh = (ai >> 2) & 1, n = (ai >> 3) & 31, b = ai >> 8;
    const int g = w >> 1, hq = kvh * 4 + g, qrow0 = n * 128 + qq * 32 + (w & 1) * 16;
    LAS unsigned char* Ks = L; LAS unsigned char* Vs = L + 34816;
    bf16x8 qf[4];
#pragma unroll
    for (int kk = 0; kk < 4; ++kk) qf[kk] = *(const bf16x8*)(qa + ((size_t)b * T + qrow0 + (lane & 15)) * 1024 + hq * 128 + 32 * kk + (lane >> 4) * 8);
    float mrun = sink[hq] * LOG2E, lsum = 1.f; f32x4 O[8];
#pragma unroll
    for (int dt = 0; dt < 8; ++dt) O[dt] = (f32x4){0.f, 0.f, 0.f, 0.f};
    const int kb_lo = n > 0 ? n - 1 : 0, kb_hi = n < 31 ? n + 1 : 31;
    v4u rk[4], rv[4];
#define AT_LOAD(kb_) do { _Pragma("unroll") for (int i_ = 0; i_ < 4; ++i_) { const int ch_ = tid + 512 * i_, r_ = ch_ >> 4, c_ = ch_ & 15; \
        rk[i_] = *(const v4u*)(ka + ((size_t)b * T + (kb_) * 128 + r_) * 256 + kvh * 128 + c_ * 8); \
        rv[i_] = *(const v4u*)(VTA + ((((size_t)b * 2 + kvh) * 32 + (kb_)) * 128 + r_) * 128 + c_ * 8); } } while (0)
    AT_LOAD(kb_lo);
    const int qpos = qrow0 + (lane & 15);
#pragma unroll 1
    for (int kb = kb_lo; kb <= kb_hi; ++kb) {
        __syncthreads();
#pragma unroll
        for (int i = 0; i < 4; ++i) { const int ch = tid + 512 * i, r = ch >> 4, c = ch & 15;
            *(LAS v4u*)(Ks + r * 272 + c * 16) = rk[i]; *(LAS v4u*)(Vs + r * 272 + c * 16) = rv[i]; }
        __syncthreads();
        if (kb < kb_hi) AT_LOAD(kb + 1);
#pragma unroll 1
        for (int kh = 0; kh < 2; ++kh) {
            const int kbase = kb * 128 + kh * 64;
            if (kbase + 63 < qrow0 - 128 || kbase > qrow0 + 15 + 128) continue;
            const LAS unsigned char* Kh = Ks + kh * (64 * 272); const LAS unsigned char* Vh = Vs + kh * 128;
            f32x4 s[4];
#pragma unroll
            for (int kt = 0; kt < 4; ++kt) { f32x4 acc = (f32x4){0.f, 0.f, 0.f, 0.f};
#pragma unroll
                for (int kk = 0; kk < 4; ++kk) { const bf16x8 kf = *(const LAS bf16x8*)(Kh + (16 * kt + (lane & 15)) * 272 + (32 * kk + (lane >> 4) * 8) * 2); acc = MFMA16(kf, qf[kk], acc); }
                s[kt] = acc; }
            float mx = -INFINITY;
#pragma unroll
            for (int kt = 0; kt < 4; ++kt)
#pragma unroll
                for (int jj = 0; jj < 4; ++jj) { const int dl = kbase + 16 * kt + (lane >> 4) * 4 + jj - qpos; if (dl > 128 || dl < -128) s[kt][jj] = -INFINITY; mx = fmaxf(mx, s[kt][jj]); }
            mx = fmaxf(mx, __shfl_xor(mx, 16)); mx = fmaxf(mx, __shfl_xor(mx, 32));
            const float mnew = fmaxf(mrun, mx), alpha = __builtin_amdgcn_exp2f(mrun - mnew);
            mrun = mnew;
            float rs = 0.f;
#pragma unroll
            for (int kt = 0; kt < 4; ++kt)
#pragma unroll
                for (int jj = 0; jj < 4; ++jj) { const float p = __builtin_amdgcn_exp2f(s[kt][jj] - mnew); s[kt][jj] = p; rs += p; }
            rs += __shfl_xor(rs, 16); rs += __shfl_xor(rs, 32);
            lsum = lsum * alpha + rs;
#pragma unroll
            for (int dt = 0; dt < 8; ++dt) O[dt] = O[dt] * alpha;
#pragma unroll
            for (int ks = 0; ks < 2; ++ks) {
                v4u pw; pw.x = pk2(s[2 * ks][0], s[2 * ks][1]); pw.y = pk2(s[2 * ks][2], s[2 * ks][3]); pw.z = pk2(s[2 * ks + 1][0], s[2 * ks + 1][1]); pw.w = pk2(s[2 * ks + 1][2], s[2 * ks + 1][3]);
                const bf16x8 pf = __builtin_bit_cast(bf16x8, pw);
#pragma unroll
                for (int dt = 0; dt < 8; ++dt) {
                    const LAS unsigned char* vp = Vh + (16 * dt + (lane & 15)) * 272 + (32 * ks + (lane >> 4) * 4) * 2;
                    const v2u v0 = *(const LAS v2u*)vp, v1 = *(const LAS v2u*)(vp + 32);
                    v4u vw; vw.x = v0.x; vw.y = v0.y; vw.z = v1.x; vw.w = v1.y;
                    O[dt] = MFMA16(__builtin_bit_cast(bf16x8, vw), pf, O[dt]);
                }
            }
        }
    }
#undef AT_LOAD
    { const float inv = 1.f / lsum;
      bf16* orow = mix + ((size_t)b * T + qrow0 + (lane & 15)) * 2048 + hq * 128 + (lane >> 4) * 4;
#pragma unroll
      for (int dt = 0; dt < 8; ++dt) { const f32x4 o = O[dt] * inv; v2u wv2; wv2.x = pk2(o[0], o[1]); wv2.y = pk2(o[2], o[3]); *(v2u*)(orow + 16 * dt) = wv2; } }
}

#define XB_TMO      128
#define XB_XCNT(j)  (256  + 64 * (j))
#define XB_XSUB(j)  (1280 + 64 * (j))
#define XB_XGEN(j)  (2304 + 64 * (j))
#define XB_TOP      3328
#define XB_TOPGEN   3392
#define XCD_BAR_WORDS 3456
#define XB_SPIN_CAP (1u << 22)
__device__ __forceinline__ unsigned xb_ld(unsigned* p)              { return __hip_atomic_load(p, __ATOMIC_RELAXED, __HIP_MEMORY_SCOPE_AGENT); }
__device__ __forceinline__ unsigned xb_add(unsigned* p, unsigned v) { return __hip_atomic_fetch_add(p, v, __ATOMIC_RELAXED, __HIP_MEMORY_SCOPE_AGENT); }
__device__ __forceinline__ unsigned xb_xcc_id() { return (unsigned)__builtin_amdgcn_s_getreg((3 << 11) | 20) & 0xFu; }
#define XB_SPIN(cond, bar) do { unsigned _sp = 0; while (cond) { __builtin_amdgcn_s_sleep(1); \
    if ((++_sp & 255u) == 0u) { if (xb_ld(&(bar)[XB_TMO])) break; if (_sp > XB_SPIN_CAP) { atomicAdd(&(bar)[XB_TMO], 1u); break; } } } } while (0)
struct XcdBarrier { unsigned* bar; unsigned x; volatile LAS unsigned* st; };
__device__ __forceinline__ XcdBarrier xcd_barrier_post(unsigned* bar, volatile LAS unsigned* st) {
    XcdBarrier b; b.bar = bar; b.x = xb_xcc_id(); b.st = st;
    if (threadIdx.x == 0) (void)xb_add(&bar[XB_XCNT(b.x)], 1u);
    return b;
}
__device__ __forceinline__ void xcd_barrier_complete(unsigned* bar, unsigned x, unsigned& nloc, unsigned& nx) {
    const unsigned G = gridDim.x * gridDim.y * gridDim.z;
    unsigned sum, cnt, mine, sp = 0u;
    for (;;) {
        sum = 0u; cnt = 0u; mine = 0u;
#pragma unroll
        for (unsigned j = 0; j < 16; ++j) { const unsigned c = xb_ld(&bar[XB_XCNT(j)]); sum += c; cnt += (c > 0u) ? 1u : 0u; mine = (j == x) ? c : mine; }
        if (sum == G) break;
        __builtin_amdgcn_s_sleep(1);
        if ((++sp & 255u) == 0u) { if (xb_ld(&bar[XB_TMO])) break; if (sp > XB_SPIN_CAP) { atomicAdd(&bar[XB_TMO], 1u); break; } }
    }
    nloc = mine > 0u ? mine : 1u; nx = cnt > 0u ? cnt : 1u;
}
__device__ __forceinline__ void xcd_barrier(const XcdBarrier& b) {
    asm volatile("s_waitcnt vmcnt(0)" ::: "memory");
    __syncthreads();
    if (threadIdx.x == 0) {
        unsigned* bar = b.bar;
        __builtin_amdgcn_s_waitcnt(0);
        unsigned nloc = b.st[0], nx = b.st[1];
        if (nloc == 0u) { xcd_barrier_complete(bar, b.x, nloc, nx); b.st[0] = nloc; b.st[1] = nx; }
        const unsigned old = xb_add(&bar[XB_XSUB(b.x)], 1u);
        const unsigned gen = old / nloc;
        if (old + 1u == (gen + 1u) * nloc) {
            __builtin_amdgcn_fence(__ATOMIC_RELEASE, "agent");
            asm volatile("s_waitcnt vmcnt(0)" ::: "memory");
            const unsigned og = xb_add(&bar[XB_TOP], 1u);
            const unsigned tg = og / nx;
            if (og + 1u == (tg + 1u) * nx) xb_add(&bar[XB_TOPGEN], 1u);
            else XB_SPIN(xb_ld(&bar[XB_TOPGEN]) == tg, bar);
            __builtin_amdgcn_fence(__ATOMIC_ACQUIRE, "agent");
            xb_add(&bar[XB_XGEN(b.x)], 1u);
            asm volatile("s_waitcnt vmcnt(0)" ::: "memory");
        } else {
            XB_SPIN(xb_ld(&bar[XB_XGEN(b.x)]) == gen, bar);
            __builtin_amdgcn_fence(__ATOMIC_ACQUIRE, "agent");
            asm volatile("s_waitcnt vmcnt(0)" ::: "memory");
        }
    }
    __syncthreads();
}

__global__ void __launch_bounds__(NTHR, 2) hymba_fwd(Args args) {
    extern __shared__ __attribute__((aligned(16))) unsigned char lds_raw[];
    LAS unsigned char* L = (LAS unsigned char*)lds_raw;
    cg::grid_group grid = cg::this_grid();
    const int tid = threadIdx.x, lane = tid & 63, wave = __builtin_amdgcn_readfirstlane(tid >> 6);
    const int G = gridDim.x, bx = blockIdx.x;
    const int gw = bx * NWAVES + wave, NGW = G * NWAVES;
#define KARG(i) (((volatile const __attribute__((address_space(4))) unsigned long long*)__builtin_amdgcn_kernarg_segment_ptr())[i])
#define GAS __attribute__((address_space(1)))
#define INP(i) ((const float*)(GAS const float*)KARG(i))
#define WSP(off) ((unsigned char*)((GAS unsigned char*)KARG(18) + (off)))
#define OUTP ((float*)(GAS float*)KARG(17))
    const int lo = args.ph_lo, hi = args.ph_hi;
#ifndef REPEAT_MASK
#define REPEAT_MASK 0
#endif
#ifndef PHASE_MASK
#define PHASE_MASK 0x1ff
#endif
#define IN(k) (((PHASE_MASK >> (k)) & 1) && lo <= (k) && (k) < hi)
#define SEAMX(k, k2) do { if (IN(k) && IN(k2)) xcd_barrier(xbar); } while (0)
#define SEAM(k) SEAMX(k, (k) + 1)
    if (tid < 64) ((LAS unsigned*)(L + LDS_XB))[tid] = 0u;
    __syncthreads();
    const XcdBarrier xbar = xcd_barrier_post((unsigned*)WSP(0), (volatile LAS unsigned*)(L + LDS_XB));

    if (lo < 0) grid.sync();
    if (IN(0)) for (int rep_ = 0; rep_ < 1 + ((REPEAT_MASK >> 0) & 1); ++rep_) { if (rep_) grid.sync();
        const float* x = INP(0); const float* norm1_g = INP(1); const float* w_in = INP(2); const float* w_out = INP(11); const float* w_up = INP(13); const float* w_down = INP(16); const float* norm2_g = INP(12);
        bf16* Wt_in = (bf16*)WSP(WS_WIN); bf16* Wt_out = (bf16*)WSP(WS_WOUT); bf16* Wt_up = (bf16*)WSP(WS_WUP); bf16* Wt_dn = (bf16*)WSP(WS_WDN); bf16* Hb = (bf16*)WSP(WS_H);
        LAS float* scr = (LAS float*)(L + wave * 16384);
        constexpr int I_IN = (D / 64) * (NPROJ / 32), I_UP = (D / 64) * (NUP / 32);
        const int NITEMS = I_IN + (G == 256 ? 0 : I_UP);
        for (int it = gw; it < NITEMS; it += NGW) {
            int r = it;
            if (r < I_IN) { transpose_item(w_in, D, NPROJ, Wt_in, 0, scr, r, lane); continue; } r -= I_IN;
            transpose_item(w_up, D, NUP, Wt_up, 1, scr, r, lane, norm2_g);
        }
        { v4u z = (v4u){0u, 0u, 0u, 0u}; v4u* p = (v4u*)(Wt_in + (size_t)NPROJ * D); const int nv = (NPROJ_P - NPROJ) * D / 8;
          for (int i = bx * NTHR + tid; i < nv; i += G * NTHR) p[i] = z; }
        for (int m = gw; m < M; m += 2 * NGW) {
            const int m2 = m + NGW;
            const f32x4* xa = (const f32x4*)(x + (size_t)m * D) + lane; const f32x4* xb = (const f32x4*)(x + (size_t)(m2 < M ? m2 : m) * D) + lane; const f32x4* gr = (const f32x4*)norm1_g + lane;
            f32x4 va[8], vb[8]; float sa = 0.f, sb = 0.f;
#pragma unroll
            for (int j = 0; j < 8; ++j) { va[j] = xa[64 * j]; vb[j] = xb[64 * j]; }
#pragma unroll
            for (int j = 0; j < 8; ++j) { sa += (va[j].x * va[j].x + va[j].y * va[j].y) + (va[j].z * va[j].z + va[j].w * va[j].w); sb += (vb[j].x * vb[j].x + vb[j].y * vb[j].y) + (vb[j].z * vb[j].z + vb[j].w * vb[j].w); }
            const float ra = __builtin_amdgcn_rsqf(wave_sum(sa) * (1.f / D) + EPS), rb = __builtin_amdgcn_rsqf(wave_sum(sb) * (1.f / D) + EPS);
            v2u* oa = (v2u*)(Hb + (size_t)m * D) + lane; v2u* ob2 = (v2u*)(Hb + (size_t)m2 * D) + lane;
#pragma unroll
            for (int j = 0; j < 8; ++j) { const f32x4 g = gr[64 * j];
                v2u w; w.x = pk2(va[j].x * ra * g.x, va[j].y * ra * g.y); w.y = pk2(va[j].z * ra * g.z, va[j].w * ra * g.w); oa[64 * j] = w;
                if (m2 < M) { v2u w2; w2.x = pk2(vb[j].x * rb * g.x, vb[j].y * rb * g.y); w2.y = pk2(vb[j].z * rb * g.z, vb[j].w * rb * g.w); ob2[64 * j] = w2; } }
        }
    }
    SEAM(0);
    if (IN(1)) for (int rep_ = 0; rep_ < 1 + ((REPEAT_MASK >> 1) & 1); ++rep_) { if (rep_) grid.sync();
        bf16* Wt_in = (bf16*)WSP(WS_WIN); bf16* Hb = (bf16*)WSP(WS_H); bf16* proj = (bf16*)WSP(WS_PROJ);
        pg8::Gemm g{Hb, Wt_in, M, NPROJ_P, D}; pg8::StaticOrder S; S.init(M, NPROJ_P, G, bx);
        pg8::EpiBf16 E{proj, NPROJ_P};
        pg8::gemm_phase<pg8::EpiBf16, pg8::StaticOrder, true, false>(L, g, S, E);
        { const int nwg = (M / 256) * (NPROJ_P / 256), full = nwg / G, rem = nwg - full * G;
          const float* w_out = INP(11); bf16* Wt_out = (bf16*)WSP(WS_WOUT); LAS float* scr = (LAS float*)(L + wave * 16384);
          constexpr int I_OUT = (D / 64) * (D / 32);
          if (rem > 0) { if (bx >= rem) {
              for (int it = (bx - rem) * NWAVES + wave; it < I_OUT; it += (G - rem) * NWAVES) transpose_item(w_out, D, D, Wt_out, 0, scr, it, lane);
              if (G == 256) {
                  const float* w_up = INP(13); const float* norm2_g = INP(12); bf16* Wt_up = (bf16*)WSP(WS_WUP);
                  for (int it = (bx - rem) * NWAVES + wave; it < W_UP_EARLY; it += (G - rem) * NWAVES) transpose_item(w_up, D, NUP, Wt_up, 1, scr, it, lane, norm2_g);
              } } }
          else for (int it = gw; it < I_OUT; it += NGW) transpose_item(w_out, D, D, Wt_out, 0, scr, it, lane);
        }
    }
    SEAM(1);
    if (IN(2)) for (int rep_ = 0; rep_ < 1 + ((REPEAT_MASK >> 2) & 1); ++rep_) { if (rep_) grid.sync();
        const float* qn_g = INP(3); const float* kn_g = INP(4); const float* wa2f = INP(6); const float* baf = INP(7); const float* wa2b = INP(8); const float* bab = INP(9);
        bf16* proj = (bf16*)WSP(WS_PROJ); bf16* qa = (bf16*)WSP(WS_QA); bf16* KOTb = (bf16*)WSP(WS_KOT); bf16* Abuf = (bf16*)WSP(WS_AB); bf16* QIb = (bf16*)WSP(WS_QI);
        float* DVb = (float*)WSP(WS_DV); bf16* VTG = (bf16*)WSP(WS_VTG); bf16* ka = (bf16*)WSP(WS_KA); bf16* VTA = (bf16*)WSP(WS_VTA);
        gla_prep_block(L, bx, G, proj, wa2f, baf, wa2b, bab, Abuf, QIb, KOTb, DVb);
        __syncthreads();
        {
            const float inv = exp2f(-(float)lane * (13.287712379549449f / 64.f));
            const float gq1 = qn_g[lane], gq2 = qn_g[lane + 64], gk1 = kn_g[lane], gk2 = kn_g[lane + 64];
            unsigned short r1[10], r2[10], n1[10], n2[10];
            if (gw < M) { const bf16* prow = proj + (size_t)gw * NPROJ_P;
#pragma unroll
                for (int hd = 0; hd < 10; ++hd) { r1[hd] = prow[hd * 128 + lane]; r2[hd] = prow[hd * 128 + 64 + lane]; } }
            for (int tok = gw; tok < M; tok += NGW) {
                { const int tn = tok + NGW < M ? tok + NGW : tok; const bf16* prow = proj + (size_t)tn * NPROJ_P;
#pragma unroll
                  for (int hd = 0; hd < 10; ++hd) { n1[hd] = prow[hd * 128 + lane]; n2[hd] = prow[hd * 128 + 64 + lane]; } }
                const int t = tok & (T - 1);
                const float ang = (float)t * inv;
                double rev = (double)ang * 0.15915494309189535; rev -= rint(rev);
                const float fr = (float)rev;
                const float sn = __builtin_amdgcn_sinf(fr), cs = __builtin_amdgcn_cosf(fr);
#pragma unroll
                for (int hd = 0; hd < 10; ++hd) {
                    const int c0 = hd * 128;
                    const float x1 = bf2f(r1[hd]), x2 = bf2f(r2[hd]);
                    const float r = __builtin_amdgcn_rsqf(wave_sum(x1 * x1 + x2 * x2) * (1.f / 128.f) + EPS);
                    const float y1 = x1 * r * (hd < 8 ? gq1 : gk1), y2 = x2 * r * (hd < 8 ? gq2 : gk2);
                    float o1 = y1 * cs - y2 * sn, o2 = y2 * cs + y1 * sn;
                    if (hd < 8) { o1 *= QSCALE; o2 *= QSCALE; bf16* q = qa + (size_t)tok * 1024 + c0; q[lane] = (bf16)f2bf(o1); q[lane + 64] = (bf16)f2bf(o2); }
                    else { bf16* k = ka + (size_t)tok * 256 + (hd - 8) * 128; k[lane] = (bf16)f2bf(o1); k[lane + 64] = (bf16)f2bf(o2); }
                }
#pragma unroll
                for (int hd = 0; hd < 10; ++hd) { r1[hd] = n1[hd]; r2[hd] = n2[hd]; }
            }
        }
        {
            LAS unsigned char* tl = L + wave * 9216;
            for (int ti = gw; ti < 256 * 20; ti += NGW) {
                const int rt = ti / 20, ct = ti % 20, tok0 = rt * 64;
                const int srccol = ct < 4 ? C_VA + ct * 64 : C_VG + (ct - 4) * 64;
#pragma unroll
                for (int i = 0; i < 8; ++i) { const int r = (lane >> 3) + 8 * i, c8 = lane & 7;
                    *(LAS v4u*)(tl + r * 144 + c8 * 16) = __builtin_nontemporal_load((const v4u*)(proj + (size_t)(tok0 + r) * NPROJ_P + srccol + c8 * 8)); }
                LDS_WAIT(); asm volatile("" ::: "memory");
                const int bb = tok0 / T, tpos = tok0 % T;
#pragma unroll
                for (int i = 0; i < 8; ++i) {
                    const int o = lane + 64 * i, cidx = o >> 3, tg = o & 7;
                    unsigned short v[8];
#pragma unroll
                    for (int jj = 0; jj < 8; ++jj) v[jj] = *(const LAS unsigned short*)(tl + (tg * 8 + jj) * 144 + cidx * 2);
                    v4u ov; ov.x = v[0] | ((unsigned)v[1] << 16); ov.y = v[2] | ((unsigned)v[3] << 16); ov.z = v[4] | ((unsigned)v[5] << 16); ov.w = v[6] | ((unsigned)v[7] << 16);
                    if (ct < 4) { const int kb = tpos >> 7, koff = tpos & 127, kvh = ct >> 1, d = (ct & 1) * 64 + cidx;
                        *(v4u*)(VTA + ((((size_t)bb * 2 + kvh) * 32 + kb) * 128 + d) * 128 + koff + tg * 8) = ov; }
                    else { const int cgi = ct - 4, h = cgi >> 2, e = (cgi & 3) * 64 + cidx, n = tpos >> 6;
                        *(v4u*)(VTG + ((((size_t)bb * 4 + h) * 64 + n) * 256 + e) * 64 + tg * 8) = ov; }
                }
                LDS_WAIT(); asm volatile("" ::: "memory");
            }
        }
    }
    SEAM(2);
    if (IN(3)) for (int rep_ = 0; rep_ < 1 + ((REPEAT_MASK >> 3) & 1); ++rep_) { if (rep_) grid.sync();
        const float* sink = INP(5); bf16* of = (bf16*)OUTP; bf16* ob = of + (size_t)M * 1024;
        bf16* qa = (bf16*)WSP(WS_QA); bf16* KOTb = (bf16*)WSP(WS_KOT); bf16* Abuf = (bf16*)WSP(WS_AB); bf16* QIb = (bf16*)WSP(WS_QI); bf16* mix = (bf16*)WSP(WS_MIX);
        float* DVb = (float*)WSP(WS_DV); bf16* VTG = (bf16*)WSP(WS_VTG); bf16* ka = (bf16*)WSP(WS_KA); bf16* VTA = (bf16*)WSP(WS_VTA);
        if (G == 256) {
            const int xq = bx & 7, j = bx >> 3;
            if (j < 16) gla_scan_item<false>(L, xq * 16 + j, Abuf, QIb, KOTb, DVb, VTG, of, ob, nullptr, nullptr, nullptr, -1, 1);
            else {
                const int aidx = xq * 16 + (j - 16);
                for (int ai = aidx; ai < 1024; ai += 128) attn_item(L, ai, qa, ka, VTA, sink, mix);
                __syncthreads();
                { const float* w_up = INP(13); const float* norm2_g = INP(12); bf16* Wt_up = (bf16*)WSP(WS_WUP); LAS float* scr = (LAS float*)(L + wave * 16384);
                  constexpr int I_UP = (D / 64) * (NUP / 32);
                  for (int it = W_UP_EARLY + aidx * NWAVES + wave; it < I_UP; it += 128 * NWAVES) transpose_item(w_up, D, NUP, Wt_up, 1, scr, it, lane, norm2_g); }
            }
        } else {
            for (int wi = bx; wi < 128; wi += G) gla_scan_item<false>(L, wi, Abuf, QIb, KOTb, DVb, VTG, of, ob, nullptr, nullptr, nullptr, -1, 1);
            for (int ai = bx; ai < 1024; ai += G) attn_item(L, ai, qa, ka, VTA, sink, mix);
        }
    }
    SEAM(3);
    if (IN(4)) for (int rep_ = 0; rep_ < 1 + ((REPEAT_MASK >> 4) & 1); ++rep_) { if (rep_) grid.sync();
        const float* gon_g = INP(10); const bf16* of = (const bf16*)OUTP; const bf16* ob = of + (size_t)M * 1024; bf16* proj = (bf16*)WSP(WS_PROJ); bf16* mix = (bf16*)WSP(WS_MIX);
        for (int it0 = gw; it0 < M * 4; it0 += 4 * NGW) {
            v2u a[4], c[4], gt[4]; size_t o[4]; int tk[4], hh[4];
#pragma unroll
            for (int u = 0; u < 4; ++u) { const int it = it0 + u * NGW < M * 4 ? it0 + u * NGW : it0; tk[u] = it >> 2; hh[u] = it & 3;
                o[u] = (size_t)tk[u] * 1024 + hh[u] * 256 + lane * 4;
                a[u] = __builtin_nontemporal_load((const v2u*)(of + o[u])); c[u] = __builtin_nontemporal_load((const v2u*)(ob + o[u])); gt[u] = __builtin_nontemporal_load((const v2u*)(proj + (size_t)tk[u] * NPROJ_P + C_GG + hh[u] * 256 + lane * 4)); }
            const f32x4 gn = *(const f32x4*)(gon_g + lane * 4);
#pragma unroll
            for (int u = 0; u < 4; ++u) {
                if (u > 0 && it0 + u * NGW >= M * 4) break;
                const f32x4 v = (f32x4){bflo(a[u].x) + bflo(c[u].x), bfhi(a[u].x) + bfhi(c[u].x), bflo(a[u].y) + bflo(c[u].y), bfhi(a[u].y) + bfhi(c[u].y)};
                const float r = __builtin_amdgcn_rsqf(wave_sum((v.x * v.x + v.y * v.y) + (v.z * v.z + v.w * v.w)) * (1.f / 256.f) + EPS);
                float gv[4] = {bflo(gt[u].x), bfhi(gt[u].x), bflo(gt[u].y), bfhi(gt[u].y)}, y[4];
#pragma unroll
                for (int k = 0; k < 4; ++k) { const float sg = gv[k] * __builtin_amdgcn_rcpf(1.f + __expf(-gv[k])); y[k] = v[k] * r * gn[k] * sg; }
                v2u wv2; wv2.x = pk2(y[0], y[1]); wv2.y = pk2(y[2], y[3]);
                *(v2u*)(mix + (size_t)tk[u] * 2048 + 1024 + hh[u] * 256 + lane * 4) = wv2;
            }
        }
    }
    SEAM(4);
    if (IN(5)) for (int rep_ = 0; rep_ < 1 + ((REPEAT_MASK >> 5) & 1); ++rep_) { if (rep_) grid.sync();
        const float* x = INP(0); float* out = OUTP; bf16* mix = (bf16*)WSP(WS_MIX); bf16* Wt_out = (bf16*)WSP(WS_WOUT); bf16* H2 = (bf16*)WSP(WS_H2); float* rowss = (float*)WSP(WS_RSS);
        for (int p = gw; p < H2ROWS; p += NGW) { const int b = p / PB, q = p - b * PB;
            if (b >= 4 || q < 1 || q > T) { v2u z; z.x = 0u; z.y = 0u; v2u* o8 = (v2u*)(H2 + (size_t)p * D) + lane;
#pragma unroll
                for (int j = 0; j < 8; ++j) o8[64 * j] = z; } }
        pg8::Gemm g{mix, Wt_out, M, D, D}; pg8::StaticOrder S; S.init(M, D, G, bx);
        pg8::EpiX1 E{x, H2, rowss, D};
        pg8::gemm_phase<pg8::EpiX1, pg8::StaticOrder, true, false>(L, g, S, E);
    }
    SEAMX(5, 7);
    if (IN(7)) for (int rep_ = 0; rep_ < 1 + ((REPEAT_MASK >> 7) & 1); ++rep_) { if (rep_) grid.sync();
        const float* conv_w = INP(14); const float* conv_b = INP(15); bf16* H2 = (bf16*)WSP(WS_H2); bf16* Wt_up = (bf16*)WSP(WS_WUP); bf16* act = (bf16*)WSP(WS_ACT); const float* rowss = (const float*)WSP(WS_RSS);
        pg8::Gemm g{H2, Wt_up, 67 * 256, NUP, D}; pg8::StaticOrder S; S.init(67 * 256, NUP, G, bx);
        pg8::EpiConv E{act, conv_w, conv_b, rowss};
        pg8::gemm_phase<pg8::EpiConv, pg8::StaticOrder, true, true>(L, g, S, E);
        { const int nwg = 67 * (NUP / 256), full = nwg / G, rem = nwg - full * G;
          const float* w_down = INP(16); bf16* Wt_dn = (bf16*)WSP(WS_WDN); LAS float* scr = (LAS float*)(L + wave * 16384);
          constexpr int I_DN = (DFF / 64) * (D / 32);
          if (rem > 0) { if (bx >= rem) for (int it = (bx - rem) * NWAVES + wave; it < I_DN; it += (G - rem) * NWAVES) transpose_item(w_down, DFF, D, Wt_dn, 0, scr, it, lane); }
          else for (int it = gw; it < I_DN; it += NGW) transpose_item(w_down, DFF, D, Wt_dn, 0, scr, it, lane);
        }
    }
    SEAM(7);
    if (IN(8)) for (int rep_ = 0; rep_ < 1 + ((REPEAT_MASK >> 8) & 1); ++rep_) { if (rep_) grid.sync();
        float* out = OUTP; bf16* act = (bf16*)WSP(WS_ACT); bf16* Wt_dn = (bf16*)WSP(WS_WDN);
        pg8::Gemm g{act, Wt_dn, M, D, DFF}; pg8::StaticOrder S; S.init(M, D, G, bx);
        pg8::EpiOut E{out, (const bf16*)WSP(WS_H2), D};
        pg8::gemm_phase<pg8::EpiOut, pg8::StaticOrder, true, false>(L, g, S, E);
    }
#undef IN
#undef SEAM
}

#ifndef MK_N_LAUNCHES
#define MK_N_LAUNCHES 1
#endif

extern "C" void kernel_launch(void* const* d_in, const int* in_sizes, int n_in, void* d_out, int out_size, void* d_ws, size_t ws_size, hipStream_t stream) {
    static int grid = 0;
    if (grid == 0) {
        if (n_in != 17 || out_size != M * D || ws_size < WS_END) { fprintf(stderr, "kernel_launch: unexpected shapes (n_in %d out %d ws %zu)\n", n_in, out_size, ws_size); grid = -1; return; }
        int dev = 0, cus = 0, per_cu = 0;
        hipGetDevice(&dev);
        hipDeviceGetAttribute(&cus, hipDeviceAttributeMultiprocessorCount, dev);
        if (hipFuncSetAttribute((const void*)hymba_fwd, hipFuncAttributeMaxDynamicSharedMemorySize, LDS_BYTES) != hipSuccess) { fprintf(stderr, "kernel_launch: hipFuncSetAttribute failed\n"); grid = -1; return; }
        if (hipOccupancyMaxActiveBlocksPerMultiprocessor(&per_cu, (const void*)hymba_fwd, NTHR, LDS_BYTES) != hipSuccess || per_cu < 1) { fprintf(stderr, "kernel_launch: occupancy query says %d\n", per_cu); per_cu = 1; }
        (void)hipGetLastError();
        if (per_cu > 1) per_cu = 1;
        grid = cus * per_cu;
        if (grid > 256) grid = 256;
    }
    if (grid < 0) return;
    if (hipMemsetAsync(d_ws, 0, 131072, stream) != hipSuccess) { fprintf(stderr, "kernel_launch: memset failed\n"); return; }
    Args a{};
    for (int i = 0; i < 17; ++i) a.in[i] = (const float*)d_in[i];
    a.out = (float*)d_out; a.ws = (unsigned char*)d_ws;
#if MK_N_LAUNCHES == 1
    a.ph_lo = 0; a.ph_hi = 9;
    void* kargs[] = {&a};
    hipError_t e = hipLaunchCooperativeKernel((const void*)hymba_fwd, dim3(grid), dim3(NTHR), kargs, LDS_BYTES, stream);
    if (e != hipSuccess) fprintf(stderr, "cooperative launch failed: %s (grid %d)\n", hipGetErrorString(e), grid);
#else
    for (int p = 0; p < 9; ++p) { a.ph_lo = p; a.ph_hi = p + 1; hipLaunchKernelGGL(hymba_fwd, dim3(grid), dim3(NTHR), LDS_BYTES, stream, a); }
#endif
}
```

```cpp
#include <hip/hip_runtime.h>
#include <hip/hip_cooperative_groups.h>
#include <cstdio>
#include <cstdint>
namespace cg = cooperative_groups;

#define LAS __attribute__((address_space(3)))
typedef unsigned short bf16;
typedef unsigned v4u __attribute__((ext_vector_type(4)));
typedef unsigned v2u __attribute__((ext_vector_type(2)));
typedef float f32x4 __attribute__((ext_vector_type(4)));
typedef short bf16x8 __attribute__((ext_vector_type(8)));
typedef short s16x4 __attribute__((ext_vector_type(4)));

namespace pg8 {
#define PG8_LAS __attribute__((address_space(3)))
typedef unsigned short bf16_t;
constexpr int BM = 256, BK = 64, HALF = 128, HTB = HALF * BK * 2, STAGE_BYTES = 8 * HTB, NXCD = 8, WGM = 8;

__host__ __device__ __forceinline__ int lds_byte(int r, int c) { const int st = (r >> 4) * 2 + (c >> 5), rr = r & 15, cc = c & 31, ob = rr * 64 + cc * 2; return st * 1024 + (ob ^ (((ob >> 9) & 1) << 5)); }
__host__ __device__ __forceinline__ void stage_rc(int b, int& R, int& C) { const int st = b / 1024, sb = b % 1024, swz = sb ^ (((sb >> 9) & 1) << 5); R = (st >> 1) * 16 + swz / 64; C = (st & 1) * 32 + (swz % 64) / 2; }
__host__ __device__ __forceinline__ int perm32(int rho) { const int n = rho >> 4, i = rho & 15; return 8 * (i >> 2) + 4 * n + (i & 3); }

struct Unit { int pm, pn; };
struct Gemm { const bf16_t* A; const bf16_t* Bt; int M, N, K; };

struct StaticOrder {
    int nM, nN, nwg, G, c;
    __host__ __device__ void init(int M, int N, int G_, int c_) { nM = M / BM; nN = N / BM; nwg = nM * nN; G = G_; c = c_; }
    __host__ __device__ bool next(int i, Unit& u) const {
        const long L = (long)i * G + c; if (L >= nwg) return false;
        int wgid = (int)L; { const int q = nwg / NXCD, r = nwg % NXCD, xcd = wgid % NXCD, off = wgid / NXCD; wgid = (xcd < r ? xcd * (q + 1) : r * (q + 1) + (xcd - r) * q) + off; }
        const int nig = WGM * nN, gid = wgid / nig, fm = gid * WGM, gsz = (nM - fm) < WGM ? (nM - fm) : WGM;
        u.pm = fm + ((wgid % nig) % gsz); u.pn = (wgid % nig) / gsz; return true;
    }
    __device__ __forceinline__ void a_ready(const Unit&) const {}
    __device__ __forceinline__ void done(const Unit&) const {}
};

__device__ __forceinline__ unsigned cvt_pk_bf16(float lo, float hi) { unsigned r; asm volatile("v_cvt_pk_bf16_f32 %0, %1, %2" : "=v"(r) : "v"(lo), "v"(hi)); return r; }

struct EpiBf16 {
    static constexpr bool PERM = true, AFTER_DRAIN = false;
    bf16_t* O; int ldc;
    __device__ __forceinline__ void operator()(const f32x4 (&acc)[2][2][4][2], const Unit& u, int wr, int wc, int fr, int fq) const {
        const int row0 = u.pm * BM + wr * 64 + fr; const int col0 = u.pn * BM + wc * 32 + 8 * fq;
#pragma unroll
        for (int ai = 0; ai < 2; ++ai)
#pragma unroll
            for (int m = 0; m < 4; ++m) { bf16_t* rowp = O + (size_t)(row0 + ai * HALF + m * 16) * ldc + col0;
#pragma unroll
                for (int bj = 0; bj < 2; ++bj) { const f32x4 v0 = acc[ai][bj][m][0], v1 = acc[ai][bj][m][1];
                    v4u w; w.x = cvt_pk_bf16(v0[0], v0[1]); w.y = cvt_pk_bf16(v0[2], v0[3]); w.z = cvt_pk_bf16(v1[0], v1[1]); w.w = cvt_pk_bf16(v1[2], v1[3]);
                    __builtin_nontemporal_store(w, (v4u*)(rowp + bj * HALF)); } }
    }
};
struct EpiResF32 {
    static constexpr bool PERM = true, AFTER_DRAIN = false;
    float* C; const float* R; int ldc;
    __device__ __forceinline__ void operator()(const f32x4 (&acc)[2][2][4][2], const Unit& u, int wr, int wc, int fr, int fq) const {
        const int row0 = u.pm * BM + wr * 64 + fr, col0 = u.pn * BM + wc * 32 + 8 * fq;
#pragma unroll
        for (int ai = 0; ai < 2; ++ai)
#pragma unroll
            for (int m = 0; m < 4; ++m) { const size_t ro = (size_t)(row0 + ai * HALF + m * 16) * ldc + col0;
#pragma unroll
                for (int bj = 0; bj < 2; ++bj)
#pragma unroll
                    for (int n = 0; n < 2; ++n) { const f32x4 r = *(const f32x4*)(R + ro + bj * HALF + n * 4); *(f32x4*)(C + ro + bj * HALF + n * 4) = acc[ai][bj][m][n] + r; } }
    }
};
struct EpiX1 {
    static constexpr bool PERM = true, AFTER_DRAIN = false;
    const float* R; bf16_t* H2; float* rowss; int ldc;
    __device__ __forceinline__ void operator()(const f32x4 (&acc)[2][2][4][2], const Unit& u, int wr, int wc, int fr, int fq) const {
        const int row0 = u.pm * BM + wr * 64 + fr, col0 = u.pn * BM + wc * 32 + 8 * fq;
#pragma unroll
        for (int ai = 0; ai < 2; ++ai)
#pragma unroll
            for (int m = 0; m < 4; ++m) { const int row = row0 + ai * HALF + m * 16; const size_t ro = (size_t)row * ldc + col0;
                const size_t po = (size_t)((row >> 12) * 4154 + 1 + (row & 4095)) * ldc + col0;
                float ss = 0.f;
#pragma unroll
                for (int bj = 0; bj < 2; ++bj) {
                    const f32x4 r0 = __builtin_nontemporal_load((const f32x4*)(R + ro + bj * HALF)), r1 = __builtin_nontemporal_load((const f32x4*)(R + ro + bj * HALF + 4));
                    const f32x4 v0 = acc[ai][bj][m][0] + r0, v1 = acc[ai][bj][m][1] + r1;
                    v4u w; w.x = cvt_pk_bf16(v0[0], v0[1]); w.y = cvt_pk_bf16(v0[2], v0[3]); w.z = cvt_pk_bf16(v1[0], v1[1]); w.w = cvt_pk_bf16(v1[2], v1[3]);
                    *(v4u*)(H2 + po + bj * HALF) = w;
                    ss += (v0[0] * v0[0] + v0[1] * v0[1]) + (v0[2] * v0[2] + v0[3] * v0[3]) + (v1[0] * v1[0] + v1[1] * v1[1]) + (v1[2] * v1[2] + v1[3] * v1[3]); }
                ss += __shfl_xor(ss, 16); ss += __shfl_xor(ss, 32);
                if (fq == 0) atomicAdd(rowss + row, ss);
            }
    }
};
struct EpiOut {
    static constexpr bool PERM = true, AFTER_DRAIN = false;
    float* C; const bf16_t* H2; int ldc;
    __device__ __forceinline__ void operator()(const f32x4 (&acc)[2][2][4][2], const Unit& u, int wr, int wc, int fr, int fq) const {
        const int row0 = u.pm * BM + wr * 64 + fr, col0 = u.pn * BM + wc * 32 + 8 * fq;
#pragma unroll
        for (int ai = 0; ai < 2; ++ai)
#pragma unroll
            for (int m = 0; m < 4; ++m) { const int row = row0 + ai * HALF + m * 16; const size_t ro = (size_t)row * ldc + col0;
                const size_t po = (size_t)((row >> 12) * 4154 + 1 + (row & 4095)) * ldc + col0;
#pragma unroll
                for (int bj = 0; bj < 2; ++bj) {
                    const v4u h = __builtin_nontemporal_load((const v4u*)(H2 + po + bj * HALF));
                    const f32x4 r0 = (f32x4){__builtin_bit_cast(float, h.x << 16), __builtin_bit_cast(float, h.x & 0xffff0000u), __builtin_bit_cast(float, h.y << 16), __builtin_bit_cast(float, h.y & 0xffff0000u)};
                    const f32x4 r1 = (f32x4){__builtin_bit_cast(float, h.z << 16), __builtin_bit_cast(float, h.z & 0xffff0000u), __builtin_bit_cast(float, h.w << 16), __builtin_bit_cast(float, h.w & 0xffff0000u)};
                    __builtin_nontemporal_store(acc[ai][bj][m][0] + r0, (f32x4*)(C + ro + bj * HALF)); __builtin_nontemporal_store(acc[ai][bj][m][1] + r1, (f32x4*)(C + ro + bj * HALF + 4)); }
            }
    }
};
__device__ __forceinline__ float dpp_f(float oldv, float src, int) { return src + oldv; }
template <int CTRL> __device__ __forceinline__ float dppmov(float oldv, float src) {
    return __builtin_bit_cast(float, __builtin_amdgcn_update_dpp(__builtin_bit_cast(int, oldv), __builtin_bit_cast(int, src), CTRL, 0xf, 0xf, false));
}
template <int CTRL> __device__ __forceinline__ float rormov(float src) {
    return __builtin_bit_cast(float, __builtin_amdgcn_mov_dpp(__builtin_bit_cast(int, src), CTRL, 0xf, 0xf, true));
}
struct EpiConv {
    static constexpr bool PERM = true, AFTER_DRAIN = false;
    bf16_t* act; const float* cw; const float* cb; const float* rowss;
    __device__ __forceinline__ void operator()(const f32x4 (&acc_in)[2][2][4][2], const Unit& u, int wr, int wc, int fr, int fq) const {
        constexpr int NU = 11264, FF = 5632, PB = 4154;
        const int gc0 = u.pn * 128 + wc * 32 + fq * 8;
        f32x4 acc[2][2][4][2];
#pragma unroll
        for (int ai = 0; ai < 2; ++ai)
#pragma unroll
            for (int m = 0; m < 4; ++m) {
                const int p = 62 * (4 * u.pm + 2 * ai + wr) + 16 * m + fr, b = p / PB, q = p - b * PB;
                float rr = 0.f;
                if (q >= 1 && q <= 4096 && b < 4) rr = __builtin_amdgcn_rsqf(rowss[b * 4096 + q - 1] * (1.f / 2048.f) + 1e-6f);
#pragma unroll
                for (int bj = 0; bj < 2; ++bj)
#pragma unroll
                    for (int n = 0; n < 2; ++n) acc[ai][bj][m][n] = acc_in[ai][bj][m][n] * rr;
            }
        unsigned half0[2][4][2];
#pragma unroll
        for (int n = 0; n < 2; ++n) {
            const int gc = gc0 + 4 * n;
            const f32x4 wg0 = *(const f32x4*)(cw + gc), wg1 = *(const f32x4*)(cw + NU + gc), wg2 = *(const f32x4*)(cw + 2 * NU + gc), bg = *(const f32x4*)(cb + gc);
            const f32x4 wv0 = *(const f32x4*)(cw + FF + gc), wv1 = *(const f32x4*)(cw + NU + FF + gc), wv2 = *(const f32x4*)(cw + 2 * NU + FF + gc), bv = *(const f32x4*)(cb + FF + gc);
#pragma unroll
            for (int ai = 0; ai < 2; ++ai) {
                const int slab = 4 * u.pm + 2 * ai + wr, p0 = 62 * slab;
#pragma unroll
                for (int m = 0; m < 4; ++m) {
                    float o[4];
#pragma unroll
                    for (int x = 0; x < 4; ++x) {
                        const float gcur = acc[ai][0][m][n][x], vcur = acc[ai][1][m][n][x];
                        const float gtp = (m > 0 && fr == 15) ? acc[ai][0][m - 1][n][x] : gcur, vtp = (m > 0 && fr == 15) ? acc[ai][1][m - 1][n][x] : vcur;
                        const float gtn = (m < 3 && fr == 0) ? acc[ai][0][m + 1][n][x] : gcur, vtn = (m < 3 && fr == 0) ? acc[ai][1][m + 1][n][x] : vcur;
                        const float gp = rormov<0x121>(gtp), gn = rormov<0x12F>(gtn);
                        const float vp = rormov<0x121>(vtp), vn = rormov<0x12F>(vtn);
                        const float Gv = wg0[x] * gp + wg1[x] * gcur + wg2[x] * gn + bg[x];
                        const float Vv = wv0[x] * vp + wv1[x] * vcur + wv2[x] * vn + bv[x];
                        const float sg = Gv * __builtin_amdgcn_rcpf(1.f + __builtin_amdgcn_exp2f(-1.4426950408889634f * Gv));
                        o[x] = sg * Vv;
                    }
                    if (n == 0) { half0[ai][m][0] = cvt_pk_bf16(o[0], o[1]); half0[ai][m][1] = cvt_pk_bf16(o[2], o[3]); }
                    else {
                        const int rs = 16 * m + fr, p = p0 + rs, b = p / PB, q = p - b * PB;
                        if (rs >= 1 && rs <= 62 && q >= 1 && q <= 4096 && b < 4) {
                            v4u w; w.x = half0[ai][m][0]; w.y = half0[ai][m][1]; w.z = cvt_pk_bf16(o[0], o[1]); w.w = cvt_pk_bf16(o[2], o[3]);
                            *(v4u*)(act + (size_t)(b * 4096 + q - 1) * FF + gc0) = w;
                        }
                    }
                }
            }
        }
    }
};

template <class Epi, class Sched, bool ALIGN_EPI, bool SLAB>
__device__ __forceinline__ void gemm_phase(PG8_LAS unsigned char* lds, const Gemm g, const Sched& S, const Epi& E) {
    const int tid = threadIdx.x, wid = __builtin_amdgcn_readfirstlane(tid >> 6), lane = tid & 63, wr = wid >> 2, wc = wid & 3, fr = lane & 15, fq = lane >> 4;
    const int K = g.K, nt = K / BK;
    unsigned voffA[2], voffB[2];
#pragma unroll
    for (int i = 0; i < 2; ++i) { int R, C; stage_rc(tid * 16 + i * 8192, R, C); const int Rb = Epi::PERM ? ((R & ~31) + perm32(R & 31)) : R;
        const int Ra = SLAB ? (R - 2 * (R >> 6)) : R;
        voffA[i] = (unsigned)(Ra * K + C) * 2u; voffB[i] = (unsigned)(Rb * K + C) * 2u; }
    const size_t kstep = (size_t)(BK * 2);
    const size_t hstepB = (size_t)HALF * K * 2, tstepB = 2 * hstepB;
    const size_t hstepA = SLAB ? (size_t)124 * K * 2 : hstepB, tstepA = 2 * hstepA;
    const unsigned ldsw = (unsigned)wid * 1024u;
    const int aoff = lds_byte(wr * 64 + fr, fq * 8), boff = lds_byte(wc * 32 + fr, fq * 8);
#define PG8_SA(b, h) (((b) * 2 + (h)) * HTB)
#define PG8_SB(b, h) ((4 + (b) * 2 + (h)) * HTB)
#define PG8_STAGE(bufoff, gbase, voff) do { _Pragma("unroll") for (int _i = 0; _i < 2; ++_i) \
        __builtin_amdgcn_global_load_lds((const unsigned*)((const char*)(gbase) + (voff)[_i]), (PG8_LAS unsigned*)(lds + (bufoff) + ldsw + _i * 8192), 16, 0, 0); } while (0)
#define PG8_LDA(dst, b, h) do { _Pragma("unroll") for (int m = 0; m < 4; ++m) _Pragma("unroll") for (int k = 0; k < 2; ++k) dst[m][k] = *(const PG8_LAS bf16x8*)(lds + PG8_SA(b, h) + aoff + m * 2048 + k * 1024); } while (0)
#define PG8_LDB(dst, b, h) do { _Pragma("unroll") for (int n = 0; n < 2; ++n) _Pragma("unroll") for (int k = 0; k < 2; ++k) dst[n][k] = *(const PG8_LAS bf16x8*)(lds + PG8_SB(b, h) + boff + n * 2048 + k * 1024); } while (0)
#define PG8_MMA(ai, bj, At, Bt) do { __builtin_amdgcn_s_setprio(1); _Pragma("unroll") for (int m = 0; m < 4; ++m) _Pragma("unroll") for (int n = 0; n < 2; ++n) _Pragma("unroll") for (int k = 0; k < 2; ++k) \
        acc[ai][bj][m][n] = __builtin_amdgcn_mfma_f32_16x16x32_bf16(Bt[n][k], At[m][k], acc[ai][bj][m][n], 0, 0, 0); __builtin_amdgcn_s_setprio(0); } while (0)
#define PG8_WAIT_V(n) asm volatile("s_waitcnt vmcnt(" #n ")" ::: "memory")
#define PG8_WAIT_L(n) asm volatile("s_waitcnt lgkmcnt(" #n ")" ::: "memory")
#define PG8_BAR __builtin_amdgcn_s_barrier()
#define PG8_SCHED __builtin_amdgcn_sched_barrier(0)
    Unit cur, nxt; int ui = 0;
    if (!S.next(0, cur)) return;
    f32x4 acc[2][2][4][2];
#pragma unroll
    for (int a = 0; a < 2; ++a)
#pragma unroll
        for (int b = 0; b < 2; ++b)
#pragma unroll
            for (int m = 0; m < 4; ++m)
#pragma unroll
                for (int n = 0; n < 2; ++n) acc[a][b][m][n] = (f32x4){0.f, 0.f, 0.f, 0.f};
    bf16x8 At[4][2], B0[2][2], B1[2][2];
    const char* cA = (const char*)g.A + (size_t)cur.pm * tstepA; const char* cB = (const char*)g.Bt + (size_t)cur.pn * tstepB;
    S.a_ready(cur);
    PG8_STAGE(PG8_SB(0, 0), cB, voffB); PG8_STAGE(PG8_SB(0, 1), cB + hstepB, voffB); PG8_STAGE(PG8_SA(0, 0), cA, voffA); PG8_STAGE(PG8_SA(0, 1), cA + hstepA, voffA);
    if (wr == 1) PG8_BAR;
    PG8_WAIT_V(2); PG8_BAR;
    PG8_STAGE(PG8_SB(1, 0), cB + kstep, voffB); PG8_STAGE(PG8_SA(1, 0), cA + kstep, voffA); PG8_STAGE(PG8_SB(1, 1), cB + hstepB + kstep, voffB);
    PG8_WAIT_V(6); PG8_BAR;
    for (;;) {
        const bool has_next = S.next(ui + 1, nxt);
        const char* nA = has_next ? (const char*)g.A + (size_t)nxt.pm * tstepA : cA; const char* nB = has_next ? (const char*)g.Bt + (size_t)nxt.pn * tstepB : cB;
        for (int t = 0; t < nt; t += 2) {
            const bool last = (t == nt - 2);
            const char* a1 = cA + (size_t)(t + 1) * kstep;
            const char* a2 = last ? nA : cA + (size_t)(t + 2) * kstep; const char* b2 = last ? nB : cB + (size_t)(t + 2) * kstep;
            const char* a3 = a2 + kstep; const char* b3 = b2 + kstep;
            if (last && has_next) S.a_ready(nxt);
            PG8_LDB(B0, 0, 0); PG8_LDB(B1, 0, 1); PG8_SCHED; PG8_LDA(At, 0, 0); PG8_STAGE(PG8_SA(1, 1), a1 + hstepA, voffA);
            PG8_WAIT_V(8); PG8_WAIT_L(0); PG8_BAR; PG8_MMA(0, 0, At, B0); PG8_MMA(0, 1, At, B1); PG8_BAR; PG8_SCHED;
            PG8_LDA(At, 0, 1); PG8_STAGE(PG8_SB(0, 0), b2, voffB); PG8_STAGE(PG8_SB(0, 1), b2 + hstepB, voffB); PG8_STAGE(PG8_SA(0, 0), a2, voffA);
            PG8_WAIT_V(8); PG8_WAIT_L(0); PG8_BAR; PG8_MMA(1, 0, At, B0); PG8_MMA(1, 1, At, B1); PG8_BAR; PG8_SCHED;
            PG8_LDB(B0, 1, 0); PG8_LDB(B1, 1, 1); PG8_SCHED; PG8_LDA(At, 1, 0); PG8_STAGE(PG8_SA(0, 1), a2 + hstepA, voffA);
            PG8_WAIT_V(8); PG8_WAIT_L(0); PG8_BAR; PG8_MMA(0, 0, At, B0); PG8_MMA(0, 1, At, B1); PG8_BAR; PG8_SCHED;
            PG8_LDA(At, 1, 1); PG8_STAGE(PG8_SB(1, 0), b3, voffB); PG8_STAGE(PG8_SB(1, 1), b3 + hstepB, voffB); PG8_STAGE(PG8_SA(1, 0), a3, voffA);
            PG8_WAIT_V(8); PG8_WAIT_L(0); PG8_BAR; PG8_MMA(1, 0, At, B0); PG8_MMA(1, 1, At, B1); PG8_BAR; PG8_SCHED;
        }
        if constexpr (ALIGN_EPI) { if (wr == 0) PG8_BAR; }
        E(acc, cur, wr, wc, fr, fq); S.done(cur);
        if (!has_next) break;
#pragma unroll
        for (int a = 0; a < 2; ++a)
#pragma unroll
            for (int b = 0; b < 2; ++b)
#pragma unroll
                for (int m = 0; m < 4; ++m)
#pragma unroll
                    for (int n = 0; n < 2; ++n) acc[a][b][m][n] = (f32x4){0.f, 0.f, 0.f, 0.f};
        cur = nxt; cA = nA; cB = nB; ++ui;
        if constexpr (ALIGN_EPI) { if (wr == 1) PG8_BAR; }
    }
    PG8_WAIT_V(0);
    if constexpr (!ALIGN_EPI) { if (wr == 0) PG8_BAR; }
    PG8_BAR;
#undef PG8_SA
#undef PG8_SB
#undef PG8_STAGE
#undef PG8_LDA
#undef PG8_LDB
#undef PG8_MMA
#undef PG8_WAIT_V
#undef PG8_WAIT_L
#undef PG8_BAR
#undef PG8_SCHED
}
}

constexpr int NWAVES = 8, NTHR = 512;
constexpr int BATCH = 4, T = 4096, D = 2048, M = BATCH * T;
constexpr int NPROJ = 4640, NPROJ_P = 4864;
constexpr int DFF = 5632, NUP = 11264;
constexpr int C_QA = 0, C_KA = 1024, C_VA = 1280, C_QG = 1536, C_KG = 2048, C_VG = 2560, C_GG = 3584, C_LRF = 4608;
constexpr int PB = 4154, H2ROWS = 67 * 248 + 2;
constexpr float EPS = 1e-6f;
constexpr float LOG2E = 1.4426950408889634f;
constexpr float QSCALE = 0.08838834764831845f * LOG2E;
constexpr float GLA_SC = 0.08838834764831845f;

constexpr size_t MiB = 1u << 20;
constexpr size_t WS_RSS = 65536;
constexpr size_t WS_WIN = 1 * MiB, WS_WOUT = 20 * MiB, WS_WUP = 28 * MiB, WS_WDN = 72 * MiB;
constexpr size_t WS_H = 96 * MiB;
constexpr size_t WS_QA = 96 * MiB, WS_KOT = 128 * MiB;
constexpr size_t WS_PROJ = 160 * MiB;
constexpr size_t WS_MIX = 312 * MiB;
constexpr size_t WS_AB = 376 * MiB, WS_QI = 392 * MiB, WS_DV = 424 * MiB, WS_VTG = 426 * MiB, WS_KA = 458 * MiB, WS_VTA = 466 * MiB, WS_END = 474 * MiB;
constexpr size_t WS_H2 = 160 * MiB;
constexpr size_t WS_ACT = 232 * MiB;
static_assert(WS_H2 + (size_t)H2ROWS * D * 2 <= WS_ACT && WS_ACT + (size_t)M * DFF * 2 <= WS_END, "ws map");

constexpr int LDS_BYTES = 147456;
constexpr int LDS_XB = LDS_BYTES - 1024;
constexpr int W_UP_EARLY = 3072;

typedef float f32x2_t __attribute__((ext_vector_type(2)));
typedef __bf16 bf16x2_t __attribute__((ext_vector_type(2)));
__device__ __forceinline__ unsigned pk2(float lo, float hi) { f32x2_t v = {lo, hi}; bf16x2_t b = __builtin_convertvector(v, bf16x2_t); return __builtin_bit_cast(unsigned, b); }
__device__ __forceinline__ unsigned f2bf(float f) { return pk2(f, 0.f) & 0xffffu; }
__device__ __forceinline__ float bflo(unsigned w) { return __builtin_bit_cast(float, w << 16); }
__device__ __forceinline__ float bfhi(unsigned w) { return __builtin_bit_cast(float, w & 0xffff0000u); }
__device__ __forceinline__ float bf2f(unsigned short b) { return __builtin_bit_cast(float, (unsigned)b << 16); }
__device__ __forceinline__ float wave_sum(float v) {
#pragma unroll
    for (int o = 1; o < 64; o <<= 1) v += __shfl_xor(v, o);
    return v;
}
#define LDS_WAIT() asm volatile("s_waitcnt lgkmcnt(0)" ::: "memory")
#define MFMA16(a, b, c) __builtin_amdgcn_mfma_f32_16x16x32_bf16((a), (b), (c), 0, 0, 0)

struct Args {
    const float* in[17]; float* out; unsigned char* ws; int ph_lo, ph_hi;
};

__device__ __forceinline__ void transpose_item(const float* W, int K, int N, bf16* WT, int mode, LAS float* scr, int item, int lane, const float* kgain = nullptr) {
    const int nblk = N / 32, kb = item / nblk, nb = item % nblk, k0 = 64 * kb, n0 = 32 * nb;
    int drow0 = n0;
    if (mode == 1) drow0 = (n0 < DFF) ? (n0 / 128) * 256 + (n0 % 128) : ((n0 - DFF) / 128) * 256 + 128 + ((n0 - DFF) % 128);
    float tv[32];
#pragma unroll
    for (int i = 0; i < 32; ++i) { const int kk = 2 * i + (lane >> 5); tv[i] = __builtin_nontemporal_load(W + (size_t)(k0 + kk) * N + n0 + (lane & 31)); }
    if (kgain) {
#pragma unroll
        for (int i = 0; i < 32; ++i) tv[i] *= kgain[k0 + 2 * i + (lane >> 5)];
    }
#pragma unroll
    for (int i = 0; i < 32; ++i) { const int kk = 2 * i + (lane >> 5); scr[kk * 33 + (lane & 31)] = tv[i]; }
    LDS_WAIT(); asm volatile("" ::: "memory");
    const int c = lane & 7;
#pragma unroll
    for (int j = 0; j < 4; ++j) { const int n = (lane >> 3) + 8 * j; const LAS float* s = scr + (8 * c) * 33 + n;
        v4u o; o.x = pk2(s[0 * 33], s[1 * 33]); o.y = pk2(s[2 * 33], s[3 * 33]); o.z = pk2(s[4 * 33], s[5 * 33]); o.w = pk2(s[6 * 33], s[7 * 33]);
        *(v4u*)(WT + (size_t)(drow0 + n) * K + k0 + 8 * c) = o; }
    LDS_WAIT(); asm volatile("" ::: "memory");
}
__device__ __forceinline__ void rms_row_to_bf16(const float* xrow, const float* gain, bf16* orow, int lane) {
    const f32x4* xr = (const f32x4*)xrow + lane; const f32x4* gr = (const f32x4*)gain + lane;
    f32x4 v[8]; float s = 0.f;
#pragma unroll
    for (int j = 0; j < 8; ++j) { v[j] = __builtin_nontemporal_load(xr + 64 * j); s += (v[j].x * v[j].x + v[j].y * v[j].y) + (v[j].z * v[j].z + v[j].w * v[j].w); }
    const float r = 1.0f / sqrtf(wave_sum(s) * (1.f / D) + EPS);
    v2u* o8 = (v2u*)orow + lane;
#pragma unroll
    for (int j = 0; j < 8; ++j) { const f32x4 g = gr[64 * j]; v2u w; w.x = pk2(v[j].x * r * g.x, v[j].y * r * g.y); w.y = pk2(v[j].z * r * g.z, v[j].w * r * g.w); o8[64 * j] = w; }
}

__device__ __forceinline__ void gla_prep_block(LAS unsigned char* L, int item0, int istride, const bf16* proj, const float* wa2f, const float* baf, const float* wa2b, const float* bab,
                                              bf16* Abuf, bf16* QIb, bf16* KOTb, float* DVb) {
    const int tid = threadIdx.x, lane = tid & 63, w = __builtin_amdgcn_readfirstlane(tid >> 6);
    LAS unsigned char* Qs = L; LAS unsigned char* Ks = L + 17408; LAS unsigned char* Gs = L + 34816; LAS float* Tot = (LAS float*)(L + 68608);
    LAS float* LRs = (LAS float*)(L + 70656); LAS unsigned char* QEs = L + 78848; LAS unsigned char* KEs = L + 96256; LAS unsigned char* KOs = L + 113664;
    v4u pq[2], pk[2]; v2u plr;
    bf16x8 wBf = (bf16x8){0, 0, 0, 0, 0, 0, 0, 0}, wBb = wBf; float biasf = 0.f, biasb = 0.f; int hprev = -1;
#define GP_LOAD(it_) do { const int b_ = (it_) >> 8, h_ = ((it_) >> 6) & 3, n_ = (it_) & 63, tk_ = b_ * T + n_ * 64; \
        _Pragma("unroll") for (int i_ = 0; i_ < 2; ++i_) { const int ch_ = tid + 512 * i_, r_ = ch_ >> 4, c_ = ch_ & 15; \
            pq[i_] = __builtin_nontemporal_load((const v4u*)(proj + (size_t)(tk_ + r_) * NPROJ_P + C_QG + h_ * 128 + c_ * 8)); \
            pk[i_] = __builtin_nontemporal_load((const v4u*)(proj + (size_t)(tk_ + r_) * NPROJ_P + C_KG + h_ * 128 + c_ * 8)); } \
        { const int idx_ = tid * 4, dir_ = idx_ >> 10, r_ = (idx_ >> 4) & 63, c_ = idx_ & 15; \
          plr = *(const v2u*)(proj + (size_t)(tk_ + r_) * NPROJ_P + C_LRF + dir_ * 16 + c_); } } while (0)
    if (item0 < 1024) GP_LOAD(item0);
#pragma unroll 1
  for (int item = item0; item < 1024; item += istride) {
    const int b = item >> 8, h = (item >> 6) & 3, n = item & 63;
    if (h != hprev) { hprev = h; const int d = h * 128 + 16 * w + (lane & 15), lg = lane >> 4;
        if (lg < 2) { float a[8], c[8];
#pragma unroll
            for (int j = 0; j < 8; ++j) { a[j] = wa2f[(lg * 8 + j) * 512 + d]; c[j] = wa2b[(lg * 8 + j) * 512 + d]; }
            v4u pa, pc; pa.x = pk2(a[0], a[1]); pa.y = pk2(a[2], a[3]); pa.z = pk2(a[4], a[5]); pa.w = pk2(a[6], a[7]);
            pc.x = pk2(c[0], c[1]); pc.y = pk2(c[2], c[3]); pc.z = pk2(c[4], c[5]); pc.w = pk2(c[6], c[7]);
            wBf = __builtin_bit_cast(bf16x8, pa); wBb = __builtin_bit_cast(bf16x8, pc); }
        biasf = baf[d]; biasb = bab[d]; }
    __syncthreads();
#pragma unroll
    for (int i = 0; i < 2; ++i) { const int ch = tid + 512 * i, r = ch >> 4, c = ch & 15;
        *(LAS v4u*)(Qs + r * 272 + c * 16) = pq[i]; *(LAS v4u*)(Ks + r * 272 + c * 16) = pk[i]; }
    { const int idx = tid * 4, dir = idx >> 10, r = (idx >> 4) & 63, c = idx & 15;
      *(LAS v2u*)((LAS unsigned char*)LRs + (dir * 64 + r) * 32 + c * 2) = plr; }
    if (item + istride < 1024) GP_LOAD(item + istride);
    __syncthreads();
#pragma unroll 1
    for (int dir = 0; dir < 2; ++dir) {
        const int ci = (((b * 4 + h) * 2 + dir) * 64 + n);
        {
            const int dl = lane & 15, lg = lane >> 4;
            const float bias = dir ? biasb : biasf;
            float g[4][4];
#pragma unroll
            for (int tt = 0; tt < 4; ++tt) {
                bf16x8 a = (bf16x8){0, 0, 0, 0, 0, 0, 0, 0};
                if (lg < 2) a = *(const LAS bf16x8*)((LAS unsigned char*)LRs + (dir * 64 + 16 * tt + dl) * 32 + lg * 16);
                const f32x4 z4 = MFMA16(a, dir ? wBb : wBf, ((f32x4){0.f, 0.f, 0.f, 0.f}));
#pragma unroll
                for (int jj = 0; jj < 4; ++jj) { const float z = z4[jj] + bias; g[tt][jj] = (fminf(z, 0.f) - __logf(1.f + __expf(-fabsf(z)))) * (1.f / 16.f); }
            }
            float carry = 0.f;
#pragma unroll
            for (int k = 0; k < 4; ++k) {
                const int tt = dir ? 3 - k : k;
                float p[4];
                if (dir == 0) { p[0] = g[tt][0]; p[1] = p[0] + g[tt][1]; p[2] = p[1] + g[tt][2]; p[3] = p[2] + g[tt][3]; }
                else { p[3] = g[tt][3]; p[2] = p[3] + g[tt][2]; p[1] = p[2] + g[tt][1]; p[0] = p[1] + g[tt][0]; }
                const float gt = dir ? p[0] : p[3];
                const float t0 = __shfl(gt, dl), t1 = __shfl(gt, dl + 16), t2 = __shfl(gt, dl + 32), t3 = __shfl(gt, dl + 48);
                float excl;
                if (dir == 0) excl = (lg > 0 ? t0 : 0.f) + (lg > 1 ? t1 : 0.f) + (lg > 2 ? t2 : 0.f);
                else excl = (lg < 3 ? t3 : 0.f) + (lg < 2 ? t2 : 0.f) + (lg < 1 ? t1 : 0.f);
                const float base = carry + excl;
#pragma unroll
                for (int jj = 0; jj < 4; ++jj) *(LAS float*)(Gs + (16 * tt + 4 * lg + jj) * 528 + (16 * w + dl) * 4) = base + p[jj];
                carry += (t0 + t1) + (t2 + t3);
            }
            __syncthreads();
        }
        {
            const int t = tid >> 3, d0 = (tid & 7) * 16;
            const int tref = dir ? 31 : 32, tlast = dir ? 0 : 63;
#pragma unroll
            for (int hf = 0; hf < 2; ++hf) {
                const int dd = d0 + 8 * hf;
                const v4u q8 = *(const LAS v4u*)(Qs + t * 272 + dd * 2), k8 = *(const LAS v4u*)(Ks + t * 272 + dd * 2);
                float qv[8], kv[8], cc[8], cr[8], cl[8];
                qv[0] = bflo(q8.x); qv[1] = bfhi(q8.x); qv[2] = bflo(q8.y); qv[3] = bfhi(q8.y); qv[4] = bflo(q8.z); qv[5] = bfhi(q8.z); qv[6] = bflo(q8.w); qv[7] = bfhi(q8.w);
                kv[0] = bflo(k8.x); kv[1] = bfhi(k8.x); kv[2] = bflo(k8.y); kv[3] = bfhi(k8.y); kv[4] = bflo(k8.z); kv[5] = bfhi(k8.z); kv[6] = bflo(k8.w); kv[7] = bfhi(k8.w);
#pragma unroll
                for (int x4 = 0; x4 < 2; ++x4) {
                    const f32x4 a = *(const LAS f32x4*)(Gs + t * 528 + (dd + 4 * x4) * 4), r4 = *(const LAS f32x4*)(Gs + tref * 528 + (dd + 4 * x4) * 4), l4 = *(const LAS f32x4*)(Gs + tlast * 528 + (dd + 4 * x4) * 4);
#pragma unroll
                    for (int x = 0; x < 4; ++x) { cc[4 * x4 + x] = a[x]; cr[4 * x4 + x] = r4[x]; cl[4 * x4 + x] = l4[x]; }
                }
                float qe[8], ke[8], qi[8], ko[8];
#pragma unroll
                for (int x = 0; x < 8; ++x) { const float qq = qv[x] * GLA_SC;
                    qe[x] = qq * __expf(cc[x] - cr[x]); ke[x] = kv[x] * __expf(cr[x] - cc[x]); qi[x] = qq * __expf(cc[x]); ko[x] = kv[x] * __expf(cl[x] - cc[x]); }
                v4u o;
                o.x = pk2(qe[0], qe[1]); o.y = pk2(qe[2], qe[3]); o.z = pk2(qe[4], qe[5]); o.w = pk2(qe[6], qe[7]); *(LAS v4u*)(QEs + t * 272 + dd * 2) = o;
                o.x = pk2(ke[0], ke[1]); o.y = pk2(ke[2], ke[3]); o.z = pk2(ke[4], ke[5]); o.w = pk2(ke[6], ke[7]); *(LAS v4u*)(KEs + t * 272 + dd * 2) = o;
                o.x = pk2(ko[0], ko[1]); o.y = pk2(ko[2], ko[3]); o.z = pk2(ko[4], ko[5]); o.w = pk2(ko[6], ko[7]); *(LAS v4u*)(KOs + t * 272 + dd * 2) = o;
                o.x = pk2(qi[0], qi[1]); o.y = pk2(qi[2], qi[3]); o.z = pk2(qi[4], qi[5]); o.w = pk2(qi[6], qi[7]); *(v4u*)(QIb + ((size_t)ci * 64 + t) * 128 + dd) = o;
            }
            if (tid < 128) DVb[(size_t)ci * 128 + tid] = __expf(*(const LAS float*)(Gs + tlast * 528 + tid * 4));
            __syncthreads();
        }
        {
            const int d = tid >> 2, tq = tid & 3;
            unsigned short v[16];
#pragma unroll
            for (int i = 0; i < 16; ++i) v[i] = *(const LAS unsigned short*)(KOs + (tq * 16 + i) * 272 + d * 2);
            v4u o0, o1;
            o0.x = v[0] | ((unsigned)v[1] << 16); o0.y = v[2] | ((unsigned)v[3] << 16); o0.z = v[4] | ((unsigned)v[5] << 16); o0.w = v[6] | ((unsigned)v[7] << 16);
            o1.x = v[8] | ((unsigned)v[9] << 16); o1.y = v[10] | ((unsigned)v[11] << 16); o1.z = v[12] | ((unsigned)v[13] << 16); o1.w = v[14] | ((unsigned)v[15] << 16);
            bf16* dst = KOTb + ((size_t)ci * 128 + d) * 64 + tq * 16;
            *(v4u*)dst = o0; *(v4u*)(dst + 8) = o1;
        }
        {
#pragma unroll
            for (int tt = 0; tt < 2; ++tt) {
                const int tile = 2 * w + tt, jt = tile >> 2, it = tile & 3;
                f32x4 acc = (f32x4){0.f, 0.f, 0.f, 0.f};
#pragma unroll
                for (int kk = 0; kk < 4; ++kk) {
                    const bf16x8 a = *(const LAS bf16x8*)(KEs + (16 * jt + (lane & 15)) * 272 + (32 * kk + (lane >> 4) * 8) * 2);
                    const bf16x8 bq = *(const LAS bf16x8*)(QEs + (16 * it + (lane & 15)) * 272 + (32 * kk + (lane >> 4) * 8) * 2);
                    acc = MFMA16(a, bq, acc);
                }
                const int i = 16 * it + (lane & 15), jb = 16 * jt + (lane >> 4) * 4;
                float o[4];
#pragma unroll
                for (int jj = 0; jj < 4; ++jj) { const int j = jb + jj; const bool keep = dir ? (j > i) : (j <= i); o[jj] = keep ? acc[jj] : 0.f; }
                v2u wv2; wv2.x = pk2(o[0], o[1]); wv2.y = pk2(o[2], o[3]);
                *(v2u*)(Abuf + ((size_t)ci * 64 + i) * 64 + jb) = wv2;
            }
        }
        __syncthreads();
    }
  }
#undef GP_LOAD
}

template <bool TCONV> __device__ __forceinline__ void gla_scan_item(LAS unsigned char* L, int wi, const bf16* Abuf, const bf16* QIb, const bf16* KOTb, const float* DVb, const bf16* VTG, bf16* of, bf16* ob,
                                              const float* w_up, const float* kgain, bf16* Wt_up, int tgw, int tngw) {
    const int tid = threadIdx.x, lane = tid & 63, w = __builtin_amdgcn_readfirstlane(tid >> 6);
    const int chain = wi >> 2, sl = wi & 3, dir = chain & 1, bh = chain >> 1, b = bh >> 2, h = bh & 3;
    bf16* odir = dir ? ob : of;
    constexpr int BUFB = 54784, OA = 0, OQ = 9216, OK_ = 26624, OV = 45056, ODV = 54272, OST = 2 * BUFB, STB = 17408;
    v4u rA[2], rQ[2][2], rK[2][2], rV[2]; float rD[2];
#define GS_LOAD(s_, nn) do { const size_t ci_ = (size_t)chain * 64 + (nn); \
        rA[s_] = *(const v4u*)(Abuf + (ci_ * 64 + (tid >> 3)) * 64 + (tid & 7) * 8); \
        _Pragma("unroll") for (int i_ = 0; i_ < 2; ++i_) { const int ch_ = tid + 512 * i_; \
            rQ[s_][i_] = *(const v4u*)(QIb + (ci_ * 64 + (ch_ >> 4)) * 128 + (ch_ & 15) * 8); \
            rK[s_][i_] = *(const v4u*)(KOTb + (ci_ * 128 + (ch_ >> 3)) * 64 + (ch_ & 7) * 8); } \
        rV[s_] = *(const v4u*)(VTG + (((size_t)bh * 64 + (nn)) * 256 + sl * 64 + (tid >> 3)) * 64 + (tid & 7) * 8); \
        rD[s_] = DVb[ci_ * 128 + (tid & 127)]; } while (0)
#define GS_STORE(s_, bi) do { LAS unsigned char* B_ = L + (bi) * BUFB; \
        *(LAS v4u*)(B_ + OA + (tid >> 3) * 144 + (tid & 7) * 16) = rA[s_]; \
        _Pragma("unroll") for (int i_ = 0; i_ < 2; ++i_) { const int ch_ = tid + 512 * i_; \
            *(LAS v4u*)(B_ + OQ + (ch_ >> 4) * 272 + (ch_ & 15) * 16) = rQ[s_][i_]; \
            *(LAS v4u*)(B_ + OK_ + (ch_ >> 3) * 144 + (ch_ & 7) * 16) = rK[s_][i_]; } \
        *(LAS v4u*)(B_ + OV + (tid >> 3) * 144 + (tid & 7) * 16) = rV[s_]; \
        if (tid < 128) *(LAS float*)(B_ + ODV + tid * 4) = rD[s_]; } while (0)
    __syncthreads();
    for (int i = tid; i < STB / 4; i += NTHR) ((LAS unsigned*)(L + OST))[i] = 0u;
    f32x4 S[4];
#pragma unroll
    for (int e = 0; e < 4; ++e) S[e] = (f32x4){0.f, 0.f, 0.f, 0.f};
    { const int n0 = dir ? 63 : 0; GS_LOAD(0, n0); GS_STORE(0, 0); const int n1 = dir ? 62 : 1; GS_LOAD(1, n1); }
    __syncthreads();
    const int it = w >> 1, eh = w & 1;
    constexpr int I_UPC = (D / 64) * (NUP / 32);
    float tv[32], tl[8]; int tk0 = 0, tdrow = 0, tl_k = 0; bool tvalid = false, tl_valid = false; const float* twp = w_up; bf16* tl_dst = Wt_up;
#pragma unroll 1
    for (int step4 = 0; step4 < 16; ++step4) {
#pragma unroll
      for (int par = 0; par < 4; ++par) {
        const int step = 4 * step4 + par, cur = par & 1;
        if (TCONV && par == 0 && tl_valid) { const f32x4 g0_ = *(const f32x4*)(kgain + tl_k), g1_ = *(const f32x4*)(kgain + tl_k + 4); v4u o_;
            o_.x = pk2(tl[0] * g0_[0], tl[1] * g0_[1]); o_.y = pk2(tl[2] * g0_[2], tl[3] * g0_[3]); o_.z = pk2(tl[4] * g1_[0], tl[5] * g1_[1]); o_.w = pk2(tl[6] * g1_[2], tl[7] * g1_[3]);
            *(v4u*)tl_dst = o_; tl_valid = false; }
        const int n = dir ? 63 - step : step;
        { const int nn = dir ? (n >= 2 ? n - 2 : 0) : (n <= 61 ? n + 2 : 63); GS_LOAD(par & 1, nn); }
        if constexpr (TCONV) {
            if (par == 0) { int it_ = tgw + step4 * tngw; tvalid = tgw >= 0 && it_ < I_UPC; it_ = tvalid ? it_ : I_UPC - 1;
                const int kb_ = it_ / (NUP / 32), nb_ = it_ - kb_ * (NUP / 32); tk0 = 64 * kb_ + 32 * (lane >> 5); const int n0_ = 32 * nb_;
                tdrow = ((n0_ < DFF) ? (n0_ / 128) * 256 + (n0_ % 128) : ((n0_ - DFF) / 128) * 256 + 128 + ((n0_ - DFF) % 128)) + (lane & 31);
                twp = w_up + (size_t)tk0 * NUP + n0_ + (lane & 31); }
#pragma unroll
            for (int j_ = 0; j_ < 8; ++j_) tv[8 * par + j_] = twp[(size_t)(8 * par + j_) * NUP];
        }
        LAS unsigned char* Bc = L + cur * BUFB; LAS unsigned char* Stc = L + OST + cur * STB; LAS unsigned char* Stn = L + OST + (cur ^ 1) * STB;
        f32x4 acc0 = (f32x4){0.f, 0.f, 0.f, 0.f}, acc1 = acc0;
#pragma unroll
        for (int kk = 0; kk < 2; ++kk) { const bf16x8 a = *(const LAS bf16x8*)(Bc + OA + (16 * it + (lane & 15)) * 144 + (32 * kk + (lane >> 4) * 8) * 2);
            const bf16x8 v0 = *(const LAS bf16x8*)(Bc + OV + (32 * eh + (lane & 15)) * 144 + (32 * kk + (lane >> 4) * 8) * 2);
            const bf16x8 v1 = *(const LAS bf16x8*)(Bc + OV + (32 * eh + 16 + (lane & 15)) * 144 + (32 * kk + (lane >> 4) * 8) * 2);
            acc0 = MFMA16(v0, a, acc0); acc1 = MFMA16(v1, a, acc1); }
#pragma unroll
        for (int kk = 0; kk < 4; ++kk) { const bf16x8 a = *(const LAS bf16x8*)(Bc + OQ + (16 * it + (lane & 15)) * 272 + (32 * kk + (lane >> 4) * 8) * 2);
            const bf16x8 s0 = *(const LAS bf16x8*)(Stc + (32 * eh + (lane & 15)) * 272 + (32 * kk + (lane >> 4) * 8) * 2);
            const bf16x8 s1 = *(const LAS bf16x8*)(Stc + (32 * eh + 16 + (lane & 15)) * 272 + (32 * kk + (lane >> 4) * 8) * 2);
            acc0 = MFMA16(s0, a, acc0); acc1 = MFMA16(s1, a, acc1); }
        { const size_t tok = (size_t)b * T + n * 64 + 16 * it + (lane & 15); const int col = h * 256 + sl * 64 + 32 * eh + (lane >> 4) * 4;
          v2u w0, w1; w0.x = pk2(acc0[0], acc0[1]); w0.y = pk2(acc0[2], acc0[3]); w1.x = pk2(acc1[0], acc1[1]); w1.y = pk2(acc1[2], acc1[3]);
          *(v2u*)(odir + tok * 1024 + col) = w0; *(v2u*)(odir + tok * 1024 + col + 16) = w1; }
        { const f32x4 dsc = *(const LAS f32x4*)(Bc + ODV + (16 * w + (lane >> 4) * 4) * 4);
          bf16x8 ka[2];
#pragma unroll
          for (int kk = 0; kk < 2; ++kk) ka[kk] = *(const LAS bf16x8*)(Bc + OK_ + (16 * w + (lane & 15)) * 144 + (32 * kk + (lane >> 4) * 8) * 2);
#pragma unroll
          for (int e = 0; e < 4; ++e) { S[e] = S[e] * dsc;
#pragma unroll
              for (int kk = 0; kk < 2; ++kk) { const bf16x8 vf = *(const LAS bf16x8*)(Bc + OV + (16 * e + (lane & 15)) * 144 + (32 * kk + (lane >> 4) * 8) * 2); S[e] = MFMA16(ka[kk], vf, S[e]); }
              v2u p; p.x = pk2(S[e][0], S[e][1]); p.y = pk2(S[e][2], S[e][3]);
              *(LAS v2u*)(Stn + (16 * e + (lane & 15)) * 272 + (16 * w + (lane >> 4) * 4) * 2) = p; } }
        if (TCONV && par == 3) {
            if (tvalid) { bf16* d_ = Wt_up + (size_t)tdrow * D + tk0;
#pragma unroll
                for (int c_ = 0; c_ < 3; ++c_) { const f32x4 g0_ = *(const f32x4*)(kgain + tk0 + 8 * c_), g1_ = *(const f32x4*)(kgain + tk0 + 8 * c_ + 4); v4u o_;
                    o_.x = pk2(tv[8 * c_] * g0_[0], tv[8 * c_ + 1] * g0_[1]); o_.y = pk2(tv[8 * c_ + 2] * g0_[2], tv[8 * c_ + 3] * g0_[3]);
                    o_.z = pk2(tv[8 * c_ + 4] * g1_[0], tv[8 * c_ + 5] * g1_[1]); o_.w = pk2(tv[8 * c_ + 6] * g1_[2], tv[8 * c_ + 7] * g1_[3]);
                    *(v4u*)(d_ + 8 * c_) = o_; } }
            tl_valid = tvalid; tl_dst = Wt_up + (size_t)tdrow * D + tk0 + 24; tl_k = tk0 + 24;
#pragma unroll
            for (int j_ = 0; j_ < 8; ++j_) tl[j_] = tv[24 + j_];
        }
        if (step < 63) GS_STORE((par + 1) & 1, cur ^ 1);
        __syncthreads();
      }
    }
    if (TCONV && tl_valid) { const f32x4 g0_ = *(const f32x4*)(kgain + tl_k), g1_ = *(const f32x4*)(kgain + tl_k + 4); v4u o_;
        o_.x = pk2(tl[0] * g0_[0], tl[1] * g0_[1]); o_.y = pk2(tl[2] * g0_[2], tl[3] * g0_[3]); o_.z = pk2(tl[4] * g1_[0], tl[5] * g1_[1]); o_.w = pk2(tl[6] * g1_[2], tl[7] * g1_[3]);
        *(v4u*)tl_dst = o_; tl_valid = false; }
#undef GS_LOAD
#undef GS_STORE
}

__device__ __forceinline__ void attn_item(LAS unsigned char* L, int ai, const bf16* qa, const bf16* ka, const bf16* VTA, const float* sink, bf16* mix) {
    const int tid = threadIdx.x, lane = tid & 63, w = __builtin_amdgcn_readfirstlane(tid >> 6);
    const int qq = ai & 3, kvh = (ai >> 2) & 1, n = (ai >> 3) & 31, b = ai >> 8;
    const int g = w >> 1, hq = kvh * 4 + g, qrow0 = n * 128 + qq * 32 + (w & 1) * 16;
    LAS unsigned char* Ks = L; LAS unsigned char* Vs = L + 34816;
    bf16x8 qf[4];
#pragma unroll
    for (int kk = 0; kk < 4; ++kk) qf[kk] = *(const bf16x8*)(qa + ((size_t)b * T + qrow0 + (lane & 15)) * 1024 + hq * 128 + 32 * kk + (lane >> 4) * 8);
    float mrun = sink[hq] * LOG2E, lsum = 1.f; f32x4 O[8];
#pragma unroll
    for (int dt = 0; dt < 8; ++dt) O[dt] = (f32x4){0.f, 0.f, 0.f, 0.f};
    const int kb_lo = n > 0 ? n - 1 : 0, kb_hi = n < 31 ? n + 1 : 31;
    v4u rk[4], rv[4];
#define AT_LOAD(kb_) do { _Pragma("unroll") for (int i_ = 0; i_ < 4; ++i_) { const int ch_ = tid + 512 * i_, r_ = ch_ >> 4, c_ = ch_ & 15; \
        rk[i_] = *(const v4u*)(ka + ((size_t)b * T + (kb_) * 128 + r_) * 256 + kvh * 128 + c_ * 8); \
        rv[i_] = *(const v4u*)(VTA + ((((size_t)b * 2 + kvh) * 32 + (kb_)) * 128 + r_) * 128 + c_ * 8); } } while (0)
    AT_LOAD(kb_lo);
    const int qpos = qrow0 + (lane & 15);
#pragma unroll 1
    for (int kb = kb_lo; kb <= kb_hi; ++kb) {
        __syncthreads();
#pragma unroll
        for (int i = 0; i < 4; ++i) { const int ch = tid + 512 * i, r = ch >> 4, c = ch & 15;
            *(LAS v4u*)(Ks + r * 272 + c * 16) = rk[i]; *(LAS v4u*)(Vs + r * 272 + c * 16) = rv[i]; }
        __syncthreads();
        if (kb < kb_hi) AT_LOAD(kb + 1);
#pragma unroll 1
        for (int kh = 0; kh < 2; ++kh) {
            const int kbase = kb * 128 + kh * 64;
            if (kbase + 63 < qrow0 - 128 || kbase > qrow0 + 15 + 128) continue;
            const LAS unsigned char* Kh = Ks + kh * (64 * 272); const LAS unsigned char* Vh = Vs + kh * 128;
            f32x4 s[4];
#pragma unroll
            for (int kt = 0; kt < 4; ++kt) { f32x4 acc = (f32x4){0.f, 0.f, 0.f, 0.f};
#pragma unroll
                for (int kk = 0; kk < 4; ++kk) { const bf16x8 kf = *(const LAS bf16x8*)(Kh + (16 * kt + (lane & 15)) * 272 + (32 * kk + (lane >> 4) * 8) * 2); acc = MFMA16(kf, qf[kk], acc); }
                s[kt] = acc; }
            float mx = -INFINITY;
#pragma unroll
            for (int kt = 0; kt < 4; ++kt)
#pragma unroll
                for (int jj = 0; jj < 4; ++jj) { const int dl = kbase + 16 * kt + (lane >> 4) * 4 + jj - qpos; if (dl > 128 || dl < -128) s[kt][jj] = -INFINITY; mx = fmaxf(mx, s[kt][jj]); }
            mx = fmaxf(mx, __shfl_xor(mx, 16)); mx = fmaxf(mx, __shfl_xor(mx, 32));
            const float mnew = fmaxf(mrun, mx), alpha = __builtin_amdgcn_exp2f(mrun - mnew);
            mrun = mnew;
            float rs = 0.f;
#pragma unroll
            for (int kt = 0; kt < 4; ++kt)
#pragma unroll
                for (int jj = 0; jj < 4; ++jj) { const float p = __builtin_amdgcn_exp2f(s[kt][jj] - mnew); s[kt][jj] = p; rs += p; }
            rs += __shfl_xor(rs, 16); rs += __shfl_xor(rs, 32);
            lsum = lsum * alpha + rs;
#pragma unroll
            for (int dt = 0; dt < 8; ++dt) O[dt] = O[dt] * alpha;
#pragma unroll
            for (int ks = 0; ks < 2; ++ks) {
                v4u pw; pw.x = pk2(s[2 * ks][0], s[2 * ks][1]); pw.y = pk2(s[2 * ks][2], s[2 * ks][3]); pw.z = pk2(s[2 * ks + 1][0], s[2 * ks + 1][1]); pw.w = pk2(s[2 * ks + 1][2], s[2 * ks + 1][3]);
                const bf16x8 pf = __builtin_bit_cast(bf16x8, pw);
#pragma unroll
                for (int dt = 0; dt < 8; ++dt) {
                    const LAS unsigned char* vp = Vh + (16 * dt + (lane & 15)) * 272 + (32 * ks + (lane >> 4) * 4) * 2;
                    const v2u v0 = *(const LAS v2u*)vp, v1 = *(const LAS v2u*)(vp + 32);
                    v4u vw; vw.x = v0.x; vw.y = v0.y; vw.z = v1.x; vw.w = v1.y;
                    O[dt] = MFMA16(__builtin_bit_cast(bf16x8, vw), pf, O[dt]);
                }
            }
        }
    }
#undef AT_LOAD
    { const float inv = 1.f / lsum;
      bf16* orow = mix + ((size_t)b * T + qrow0 + (lane & 15)) * 2048 + hq * 128 + (lane >> 4) * 4;
#pragma unroll
      for (int dt = 0; dt < 8; ++dt) { const f32x4 o = O[dt] * inv; v2u wv2; wv2.x = pk2(o[0], o[1]); wv2.y = pk2(o[2], o[3]); *(v2u*)(orow + 16 * dt) = wv2; } }
}

#define XB_TMO      128
#define XB_XCNT(j)  (256  + 64 * (j))
#define XB_XSUB(j)  (1280 + 64 * (j))
#define XB_XGEN(j)  (2304 + 64 * (j))
#define XB_TOP      3328
#define XB_TOPGEN   3392
#define XCD_BAR_WORDS 3456
#define XB_SPIN_CAP (1u << 22)
__device__ __forceinline__ unsigned xb_ld(unsigned* p)              { return __hip_atomic_load(p, __ATOMIC_RELAXED, __HIP_MEMORY_SCOPE_AGENT); }
__device__ __forceinline__ unsigned xb_add(unsigned* p, unsigned v) { return __hip_atomic_fetch_add(p, v, __ATOMIC_RELAXED, __HIP_MEMORY_SCOPE_AGENT); }
__device__ __forceinline__ unsigned xb_xcc_id() { return (unsigned)__builtin_amdgcn_s_getreg((3 << 11) | 20) & 0xFu; }
#define XB_SPIN(cond, bar) do { unsigned _sp = 0; while (cond) { __builtin_amdgcn_s_sleep(1); \
    if ((++_sp & 255u) == 0u) { if (xb_ld(&(bar)[XB_TMO])) break; if (_sp > XB_SPIN_CAP) { atomicAdd(&(bar)[XB_TMO], 1u); break; } } } } while (0)
struct XcdBarrier { unsigned* bar; unsigned x; volatile LAS unsigned* st; };
__device__ __forceinline__ XcdBarrier xcd_barrier_post(unsigned* bar, volatile LAS unsigned* st) {
    XcdBarrier b; b.bar = bar; b.x = xb_xcc_id(); b.st = st;
    if (threadIdx.x == 0) (void)xb_add(&bar[XB_XCNT(b.x)], 1u);
    return b;
}
__device__ __forceinline__ void xcd_barrier_complete(unsigned* bar, unsigned x, unsigned& nloc, unsigned& nx) {
    const unsigned G = gridDim.x * gridDim.y * gridDim.z;
    unsigned sum, cnt, mine, sp = 0u;
    for (;;) {
        sum = 0u; cnt = 0u; mine = 0u;
#pragma unroll
        for (unsigned j = 0; j < 16; ++j) { const unsigned c = xb_ld(&bar[XB_XCNT(j)]); sum += c; cnt += (c > 0u) ? 1u : 0u; mine = (j == x) ? c : mine; }
        if (sum == G) break;
        __builtin_amdgcn_s_sleep(1);
        if ((++sp & 255u) == 0u) { if (xb_ld(&bar[XB_TMO])) break; if (sp > XB_SPIN_CAP) { atomicAdd(&bar[XB_TMO], 1u); break; } }
    }
    nloc = mine > 0u ? mine : 1u; nx = cnt > 0u ? cnt : 1u;
}
__device__ __forceinline__ void xcd_barrier(const XcdBarrier& b) {
    asm volatile("s_waitcnt vmcnt(0)" ::: "memory");
    __syncthreads();
    if (threadIdx.x == 0) {
        unsigned* bar = b.bar;
        __builtin_amdgcn_s_waitcnt(0);
        unsigned nloc = b.st[0], nx = b.st[1];
        if (nloc == 0u) { xcd_barrier_complete(bar, b.x, nloc, nx); b.st[0] = nloc; b.st[1] = nx; }
        const unsigned old = xb_add(&bar[XB_XSUB(b.x)], 1u);
        const unsigned gen = old / nloc;
        if (old + 1u == (gen + 1u) * nloc) {
            __builtin_amdgcn_fence(__ATOMIC_RELEASE, "agent");
            asm volatile("s_waitcnt vmcnt(0)" ::: "memory");
            const unsigned og = xb_add(&bar[XB_TOP], 1u);
            const unsigned tg = og / nx;
            if (og + 1u == (tg + 1u) * nx) xb_add(&bar[XB_TOPGEN], 1u);
            else XB_SPIN(xb_ld(&bar[XB_TOPGEN]) == tg, bar);
            __builtin_amdgcn_fence(__ATOMIC_ACQUIRE, "agent");
            xb_add(&bar[XB_XGEN(b.x)], 1u);
            asm volatile("s_waitcnt vmcnt(0)" ::: "memory");
        } else {
            XB_SPIN(xb_ld(&bar[XB_XGEN(b.x)]) == gen, bar);
            __builtin_amdgcn_fence(__ATOMIC_ACQUIRE, "agent");
            asm volatile("s_waitcnt vmcnt(0)" ::: "memory");
        }
    }
    __syncthreads();
}

__global__ void __launch_bounds__(NTHR, 2) hymba_fwd(Args args) {
    extern __shared__ __attribute__((aligned(16))) unsigned char lds_raw[];
    LAS unsigned char* L = (LAS unsigned char*)lds_raw;
    cg::grid_group grid = cg::this_grid();
    const int tid = threadIdx.x, lane = tid & 63, wave = __builtin_amdgcn_readfirstlane(tid >> 6);
    const int G = gridDim.x, bx = blockIdx.x;
    const int gw = bx * NWAVES + wave, NGW = G * NWAVES;
#define KARG(i) (((volatile const __attribute__((address_space(4))) unsigned long long*)__builtin_amdgcn_kernarg_segment_ptr())[i])
#define GAS __attribute__((address_space(1)))
#define INP(i) ((const float*)(GAS const float*)KARG(i))
#define WSP(off) ((unsigned char*)((GAS unsigned char*)KARG(18) + (off)))
#define OUTP ((float*)(GAS float*)KARG(17))
    const int lo = args.ph_lo, hi = args.ph_hi;
#ifndef REPEAT_MASK
#define REPEAT_MASK 0
#endif
#ifndef PHASE_MASK
#define PHASE_MASK 0x1ff
#endif
#define IN(k) (((PHASE_MASK >> (k)) & 1) && lo <= (k) && (k) < hi)
#define SEAMX(k, k2) do { if (IN(k) && IN(k2)) xcd_barrier(xbar); } while (0)
#define SEAM(k) SEAMX(k, (k) + 1)
    if (tid < 64) ((LAS unsigned*)(L + LDS_XB))[tid] = 0u;
    __syncthreads();
    const XcdBarrier xbar = xcd_barrier_post((unsigned*)WSP(0), (volatile LAS unsigned*)(L + LDS_XB));

    if (lo < 0) grid.sync();
    if (IN(0)) for (int rep_ = 0; rep_ < 1 + ((REPEAT_MASK >> 0) & 1); ++rep_) { if (rep_) grid.sync();
        const float* x = INP(0); const float* norm1_g = INP(1); const float* w_in = INP(2); const float* w_out = INP(11); const float* w_up = INP(13); const float* w_down = INP(16); const float* norm2_g = INP(12);
        bf16* Wt_in = (bf16*)WSP(WS_WIN); bf16* Wt_out = (bf16*)WSP(WS_WOUT); bf16* Wt_up = (bf16*)WSP(WS_WUP); bf16* Wt_dn = (bf16*)WSP(WS_WDN); bf16* Hb = (bf16*)WSP(WS_H);
        LAS float* scr = (LAS float*)(L + wave * 16384);
        constexpr int I_IN = (D / 64) * (NPROJ / 32), I_UP = (D / 64) * (NUP / 32);
        const int NITEMS = I_IN + (G == 256 ? 0 : I_UP);
        for (int it = gw; it < NITEMS; it += NGW) {
            int r = it;
            if (r < I_IN) { transpose_item(w_in, D, NPROJ, Wt_in, 0, scr, r, lane); continue; } r -= I_IN;
            transpose_item(w_up, D, NUP, Wt_up, 1, scr, r, lane, norm2_g);
        }
        { v4u z = (v4u){0u, 0u, 0u, 0u}; v4u* p = (v4u*)(Wt_in + (size_t)NPROJ * D); const int nv = (NPROJ_P - NPROJ) * D / 8;
          for (int i = bx * NTHR + tid; i < nv; i += G * NTHR) p[i] = z; }
        for (int m = gw; m < M; m += 2 * NGW) {
            const int m2 = m + NGW;
            const f32x4* xa = (const f32x4*)(x + (size_t)m * D) + lane; const f32x4* xb = (const f32x4*)(x + (size_t)(m2 < M ? m2 : m) * D) + lane; const f32x4* gr = (const f32x4*)norm1_g + lane;
            f32x4 va[8], vb[8]; float sa = 0.f, sb = 0.f;
#pragma unroll
            for (int j = 0; j < 8; ++j) { va[j] = xa[64 * j]; vb[j] = xb[64 * j]; }
#pragma unroll
            for (int j = 0; j < 8; ++j) { sa += (va[j].x * va[j].x + va[j].y * va[j].y) + (va[j].z * va[j].z + va[j].w * va[j].w); sb += (vb[j].x * vb[j].x + vb[j].y * vb[j].y) + (vb[j].z * vb[j].z + vb[j].w * vb[j].w); }
            const float ra = __builtin_amdgcn_rsqf(wave_sum(sa) * (1.f / D) + EPS), rb = __builtin_amdgcn_rsqf(wave_sum(sb) * (1.f / D) + EPS);
            v2u* oa = (v2u*)(Hb + (size_t)m * D) + lane; v2u* ob2 = (v2u*)(Hb + (size_t)m2 * D) + lane;
#pragma unroll
            for (int j = 0; j < 8; ++j) { const f32x4 g = gr[64 * j];
                v2u w; w.x = pk2(va[j].x * ra * g.x, va[j].y * ra * g.y); w.y = pk2(va[j].z * ra * g.z, va[j].w * ra * g.w); oa[64 * j] = w;
                if (m2 < M) { v2u w2; w2.x = pk2(vb[j].x * rb * g.x, vb[j].y * rb * g.y); w2.y = pk2(vb[j].z * rb * g.z, vb[j].w * rb * g.w); ob2[64 * j] = w2; } }
        }
    }
    SEAM(0);
    if (IN(1)) for (int rep_ = 0; rep_ < 1 + ((REPEAT_MASK >> 1) & 1); ++rep_) { if (rep_) grid.sync();
        bf16* Wt_in = (bf16*)WSP(WS_WIN); bf16* Hb = (bf16*)WSP(WS_H); bf16* proj = (bf16*)WSP(WS_PROJ);
        pg8::Gemm g{Hb, Wt_in, M, NPROJ_P, D}; pg8::StaticOrder S; S.init(M, NPROJ_P, G, bx);
        pg8::EpiBf16 E{proj, NPROJ_P};
        pg8::gemm_phase<pg8::EpiBf16, pg8::StaticOrder, true, false>(L, g, S, E);
        { const int nwg = (M / 256) * (NPROJ_P / 256), full = nwg / G, rem = nwg - full * G;
          const float* w_out = INP(11); bf16* Wt_out = (bf16*)WSP(WS_WOUT); LAS float* scr = (LAS float*)(L + wave * 16384);
          constexpr int I_OUT = (D / 64) * (D / 32);
          if (rem > 0) { if (bx >= rem) {
              for (int it = (bx - rem) * NWAVES + wave; it < I_OUT; it += (G - rem) * NWAVES) transpose_item(w_out, D, D, Wt_out, 0, scr, it, lane);
              if (G == 256) {
                  const float* w_up = INP(13); const float* norm2_g = INP(12); bf16* Wt_up = (bf16*)WSP(WS_WUP);
                  for (int it = (bx - rem) * NWAVES + wave; it < W_UP_EARLY; it += (G - rem) * NWAVES) transpose_item(w_up, D, NUP, Wt_up, 1, scr, it, lane, norm2_g);
              } } }
          else for (int it = gw; it < I_OUT; it += NGW) transpose_item(w_out, D, D, Wt_out, 0, scr, it, lane);
        }
    }
    SEAM(1);
    if (IN(2)) for (int rep_ = 0; rep_ < 1 + ((REPEAT_MASK >> 2) & 1); ++rep_) { if (rep_) grid.sync();
        const float* qn_g = INP(3); const float* kn_g = INP(4); const float* wa2f = INP(6); const float* baf = INP(7); const float* wa2b = INP(8); const float* bab = INP(9);
        bf16* proj = (bf16*)WSP(WS_PROJ); bf16* qa = (bf16*)WSP(WS_QA); bf16* KOTb = (bf16*)WSP(WS_KOT); bf16* Abuf = (bf16*)WSP(WS_AB); bf16* QIb = (bf16*)WSP(WS_QI);
        float* DVb = (float*)WSP(WS_DV); bf16* VTG = (bf16*)WSP(WS_VTG); bf16* ka = (bf16*)WSP(WS_KA); bf16* VTA = (bf16*)WSP(WS_VTA);
        gla_prep_block(L, bx, G, proj, wa2f, baf, wa2b, bab, Abuf, QIb, KOTb, DVb);
        __syncthreads();
        {
            const float inv = exp2f(-(float)lane * (13.287712379549449f / 64.f));
            const float gq1 = qn_g[lane], gq2 = qn_g[lane + 64], gk1 = kn_g[lane], gk2 = kn_g[lane + 64];
            unsigned short r1[10], r2[10], n1[10], n2[10];
            if (gw < M) { const bf16* prow = proj + (size_t)gw * NPROJ_P;
#pragma unroll
                for (int hd = 0; hd < 10; ++hd) { r1[hd] = prow[hd * 128 + lane]; r2[hd] = prow[hd * 128 + 64 + lane]; } }
            for (int tok = gw; tok < M; tok += NGW) {
                { const int tn = tok + NGW < M ? tok + NGW : tok; const bf16* prow = proj + (size_t)tn * NPROJ_P;
#pragma unroll
                  for (int hd = 0; hd < 10; ++hd) { n1[hd] = prow[hd * 128 + lane]; n2[hd] = prow[hd * 128 + 64 + lane]; } }
                const int t = tok & (T - 1);
                const float ang = (float)t * inv;
                double rev = (double)ang * 0.15915494309189535; rev -= rint(rev);
                const float fr = (float)rev;
                const float sn = __builtin_amdgcn_sinf(fr), cs = __builtin_amdgcn_cosf(fr);
#pragma unroll
                for (int hd = 0; hd < 10; ++hd) {
                    const int c0 = hd * 128;
                    const float x1 = bf2f(r1[hd]), x2 = bf2f(r2[hd]);
                    const float r = __builtin_amdgcn_rsqf(wave_sum(x1 * x1 + x2 * x2) * (1.f / 128.f) + EPS);
                    const float y1 = x1 * r * (hd < 8 ? gq1 : gk1), y2 = x2 * r * (hd < 8 ? gq2 : gk2);
                    float o1 = y1 * cs - y2 * sn, o2 = y2 * cs + y1 * sn;
                    if (hd < 8) { o1 *= QSCALE; o2 *= QSCALE; bf16* q = qa + (size_t)tok * 1024 + c0; q[lane] = (bf16)f2bf(o1); q[lane + 64] = (bf16)f2bf(o2); }
                    else { bf16* k = ka + (size_t)tok * 256 + (hd - 8) * 128; k[lane] = (bf16)f2bf(o1); k[lane + 64] = (bf16)f2bf(o2); }
                }
#pragma unroll
                for (int hd = 0; hd < 10; ++hd) { r1[hd] = n1[hd]; r2[hd] = n2[hd]; }
            }
        }
        {
            LAS unsigned char* tl = L + wave * 9216;
            for (int ti = gw; ti < 256 * 20; ti += NGW) {
                const int rt = ti / 20, ct = ti % 20, tok0 = rt * 64;
                const int srccol = ct < 4 ? C_VA + ct * 64 : C_VG + (ct - 4) * 64;
#pragma unroll
                for (int i = 0; i < 8; ++i) { const int r = (lane >> 3) + 8 * i, c8 = lane & 7;
                    *(LAS v4u*)(tl + r * 144 + c8 * 16) = __builtin_nontemporal_load((const v4u*)(proj + (size_t)(tok0 + r) * NPROJ_P + srccol + c8 * 8)); }
                LDS_WAIT(); asm volatile("" ::: "memory");
                const int bb = tok0 / T, tpos = tok0 % T;
#pragma unroll
                for (int i = 0; i < 8; ++i) {
                    const int o = lane + 64 * i, cidx = o >> 3, tg = o & 7;
                    unsigned short v[8];
#pragma unroll
                    for (int jj = 0; jj < 8; ++jj) v[jj] = *(const LAS unsigned short*)(tl + (tg * 8 + jj) * 144 + cidx * 2);
                    v4u ov; ov.x = v[0] | ((unsigned)v[1] << 16); ov.y = v[2] | ((unsigned)v[3] << 16); ov.z = v[4] | ((unsigned)v[5] << 16); ov.w = v[6] | ((unsigned)v[7] << 16);
                    if (ct < 4) { const int kb = tpos >> 7, koff = tpos & 127, kvh = ct >> 1, d = (ct & 1) * 64 + cidx;
                        *(v4u*)(VTA + ((((size_t)bb * 2 + kvh) * 32 + kb) * 128 + d) * 128 + koff + tg * 8) = ov; }
                    else { const int cgi = ct - 4, h = cgi >> 2, e = (cgi & 3) * 64 + cidx, n = tpos >> 6;
                        *(v4u*)(VTG + ((((size_t)bb * 4 + h) * 64 + n) * 256 + e) * 64 + tg * 8) = ov; }
                }
                LDS_WAIT(); asm volatile("" ::: "memory");
            }
        }
    }
    SEAM(2);
    if (IN(3)) for (int rep_ = 0; rep_ < 1 + ((REPEAT_MASK >> 3) & 1); ++rep_) { if (rep_) grid.sync();
        const float* sink = INP(5); bf16* of = (bf16*)OUTP; bf16* ob = of + (size_t)M * 1024;
        bf16* qa = (bf16*)WSP(WS_QA); bf16* KOTb = (bf16*)WSP(WS_KOT); bf16* Abuf = (bf16*)WSP(WS_AB); bf16* QIb = (bf16*)WSP(WS_QI); bf16* mix = (bf16*)WSP(WS_MIX);
        float* DVb = (float*)WSP(WS_DV); bf16* VTG = (bf16*)WSP(WS_VTG); bf16* ka = (bf16*)WSP(WS_KA); bf16* VTA = (bf16*)WSP(WS_VTA);
        if (G == 256) {
            const int xq = bx & 7, j = bx >> 3;
            if (j < 16) gla_scan_item<false>(L, xq * 16 + j, Abuf, QIb, KOTb, DVb, VTG, of, ob, nullptr, nullptr, nullptr, -1, 1);
            else {
                const int aidx = xq * 16 + (j - 16);
                for (int ai = aidx; ai < 1024; ai += 128) attn_item(L, ai, qa, ka, VTA, sink, mix);
                __syncthreads();
                { const float* w_up = INP(13); const float* norm2_g = INP(12); bf16* Wt_up = (bf16*)WSP(WS_WUP); LAS float* scr = (LAS float*)(L + wave * 16384);
                  constexpr int I_UP = (D / 64) * (NUP / 32);
                  for (int it = W_UP_EARLY + aidx * NWAVES + wave; it < I_UP; it += 128 * NWAVES) transpose_item(w_up, D, NUP, Wt_up, 1, scr, it, lane, norm2_g); }
            }
        } else {
            for (int wi = bx; wi < 128; wi += G) gla_scan_item<false>(L, wi, Abuf, QIb, KOTb, DVb, VTG, of, ob, nullptr, nullptr, nullptr, -1, 1);
            for (int ai = bx; ai < 1024; ai += G) attn_item(L, ai, qa, ka, VTA, sink, mix);
        }
    }
    SEAM(3);
    if (IN(4)) for (int rep_ = 0; rep_ < 1 + ((REPEAT_MASK >> 4) & 1); ++rep_) { if (rep_) grid.sync();
        const float* gon_g = INP(10); const bf16* of = (const bf16*)OUTP; const bf16* ob = of + (size_t)M * 1024; bf16* proj = (bf16*)WSP(WS_PROJ); bf16* mix = (bf16*)WSP(WS_MIX);
        for (int it0 = gw; it0 < M * 4; it0 += 4 * NGW) {
            v2u a[4], c[4], gt[4]; size_t o[4]; int tk[4], hh[4];
#pragma unroll
            for (int u = 0; u < 4; ++u) { const int it = it0 + u * NGW < M * 4 ? it0 + u * NGW : it0; tk[u] = it >> 2; hh[u] = it & 3;
                o[u] = (size_t)tk[u] * 1024 + hh[u] * 256 + lane * 4;
                a[u] = __builtin_nontemporal_load((const v2u*)(of + o[u])); c[u] = __builtin_nontemporal_load((const v2u*)(ob + o[u])); gt[u] = __builtin_nontemporal_load((const v2u*)(proj + (size_t)tk[u] * NPROJ_P + C_GG + hh[u] * 256 + lane * 4)); }
            const f32x4 gn = *(const f32x4*)(gon_g + lane * 4);
#pragma unroll
            for (int u = 0; u < 4; ++u) {
                if (u > 0 && it0 + u * NGW >= M * 4) break;
                const f32x4 v = (f32x4){bflo(a[u].x) + bflo(c[u].x), bfhi(a[u].x) + bfhi(c[u].x), bflo(a[u].y) + bflo(c[u].y), bfhi(a[u].y) + bfhi(c[u].y)};
                const float r = __builtin_amdgcn_rsqf(wave_sum((v.x * v.x + v.y * v.y) + (v.z * v.z + v.w * v.w)) * (1.f / 256.f) + EPS);
                float gv[4] = {bflo(gt[u].x), bfhi(gt[u].x), bflo(gt[u].y), bfhi(gt[u].y)}, y[4];
#pragma unroll
                for (int k = 0; k < 4; ++k) { const float sg = gv[k] * __builtin_amdgcn_rcpf(1.f + __expf(-gv[k])); y[k] = v[k] * r * gn[k] * sg; }
                v2u wv2; wv2.x = pk2(y[0], y[1]); wv2.y = pk2(y[2], y[3]);
                *(v2u*)(mix + (size_t)tk[u] * 2048 + 1024 + hh[u] * 256 + lane * 4) = wv2;
            }
        }
    }
    SEAM(4);
    if (IN(5)) for (int rep_ = 0; rep_ < 1 + ((REPEAT_MASK >> 5) & 1); ++rep_) { if (rep_) grid.sync();
        const float* x = INP(0); float* out = OUTP; bf16* mix = (bf16*)WSP(WS_MIX); bf16* Wt_out = (bf16*)WSP(WS_WOUT); bf16* H2 = (bf16*)WSP(WS_H2); float* rowss = (float*)WSP(WS_RSS);
        for (int p = gw; p < H2ROWS; p += NGW) { const int b = p / PB, q = p - b * PB;
            if (b >= 4 || q < 1 || q > T) { v2u z; z.x = 0u; z.y = 0u; v2u* o8 = (v2u*)(H2 + (size_t)p * D) + lane;
#pragma unroll
                for (int j = 0; j < 8; ++j) o8[64 * j] = z; } }
        pg8::Gemm g{mix, Wt_out, M, D, D}; pg8::StaticOrder S; S.init(M, D, G, bx);
        pg8::EpiX1 E{x, H2, rowss, D};
        pg8::gemm_phase<pg8::EpiX1, pg8::StaticOrder, true, false>(L, g, S, E);
    }
    SEAMX(5, 7);
    if (IN(7)) for (int rep_ = 0; rep_ < 1 + ((REPEAT_MASK >> 7) & 1); ++rep_) { if (rep_) grid.sync();
        const float* conv_w = INP(14); const float* conv_b = INP(15); bf16* H2 = (bf16*)WSP(WS_H2); bf16* Wt_up = (bf16*)WSP(WS_WUP); bf16* act = (bf16*)WSP(WS_ACT); const float* rowss = (const float*)WSP(WS_RSS);
        pg8::Gemm g{H2, Wt_up, 67 * 256, NUP, D}; pg8::StaticOrder S; S.init(67 * 256, NUP, G, bx);
        pg8::EpiConv E{act, conv_w, conv_b, rowss};
        pg8::gemm_phase<pg8::EpiConv, pg8::StaticOrder, true, true>(L, g, S, E);
        { const int nwg = 67 * (NUP / 256), full = nwg / G, rem = nwg - full * G;
          const float* w_down = INP(16); bf16* Wt_dn = (bf16*)WSP(WS_WDN); LAS float* scr = (LAS float*)(L + wave * 16384);
          constexpr int I_DN = (DFF / 64) * (D / 32);
          if (rem > 0) { if (bx >= rem) for (int it = (bx - rem) * NWAVES + wave; it < I_DN; it += (G - rem) * NWAVES) transpose_item(w_down, DFF, D, Wt_dn, 0, scr, it, lane); }
          else for (int it = gw; it < I_DN; it += NGW) transpose_item(w_down, DFF, D, Wt_dn, 0, scr, it, lane);
        }
    }
    SEAM(7);
    if (IN(8)) for (int rep_ = 0; rep_ < 1 + ((REPEAT_MASK >> 8) & 1); ++rep_) { if (rep_) grid.sync();
        float* out = OUTP; bf16* act = (bf16*)WSP(WS_ACT); bf16* Wt_dn = (bf16*)WSP(WS_WDN);
        pg8::Gemm g{act, Wt_dn, M, D, DFF}; pg8::StaticOrder S; S.init(M, D, G, bx);
        pg8::EpiOut E{out, (const bf16*)WSP(WS_H2), D};
        pg8::gemm_phase<pg8::EpiOut, pg8::StaticOrder, true, false>(L, g, S, E);
    }
#undef IN
#undef SEAM
}

#ifndef MK_N_LAUNCHES
#define MK_N_LAUNCHES 1
#endif

extern "C" void kernel_launch(void* const* d_in, const int* in_sizes, int n_in, void* d_out, int out_size, void* d_ws, size_t ws_size, hipStream_t stream) {
    static int grid = 0;
    if (grid == 0) {
        if (n_in != 17 || out_size != M * D || ws_size < WS_END) { fprintf(stderr, "kernel_launch: unexpected shapes (n_in %d out %d ws %zu)\n", n_in, out_size, ws_size); grid = -1; return; }
        int dev = 0, cus = 0, per_cu = 0;
        hipGetDevice(&dev);
        hipDeviceGetAttribute(&cus, hipDeviceAttributeMultiprocessorCount, dev);
        if (hipFuncSetAttribute((const void*)hymba_fwd, hipFuncAttributeMaxDynamicSharedMemorySize, LDS_BYTES) != hipSuccess) { fprintf(stderr, "kernel_launch: hipFuncSetAttribute failed\n"); grid = -1; return; }
        if (hipOccupancyMaxActiveBlocksPerMultiprocessor(&per_cu, (const void*)hymba_fwd, NTHR, LDS_BYTES) != hipSuccess || per_cu < 1) { fprintf(stderr, "kernel_launch: occupancy query says %d\n", per_cu); per_cu = 1; }
        (void)hipGetLastError();
        if (per_cu > 1) per_cu = 1;
        grid = cus * per_cu;
        if (grid > 256) grid = 256;
    }
    if (grid < 0) return;
    if (hipMemsetAsync(d_ws, 0, 131072, stream) != hipSuccess) { fprintf(stderr, "kernel_launch: memset failed\n"); return; }
    Args a{};
    for (int i = 0; i < 17; ++i) a.in[i] = (const float*)d_in[i];
    a.out = (float*)d_out; a.ws = (unsigned char*)d_ws;
#if MK_N_LAUNCHES == 1
    a.ph_lo = 0; a.ph_hi = 9;
    void* kargs[] = {&a};
    hipError_t e = hipLaunchCooperativeKernel((const void*)hymba_fwd, dim3(grid), dim3(NTHR), kargs, LDS_BYTES, stream);
    if (e != hipSuccess) fprintf(stderr, "cooperative launch failed: %s (grid %d)\n", hipGetErrorString(e), grid);
#else
    for (int p = 0; p < 9; ++p) { a.ph_lo = p; a.ph_hi = p + 1; hipLaunchKernelGGL(hymba_fwd, dim3(grid), dim3(NTHR), LDS_BYTES, stream, a); }
#endif
}
```

```cpp
#include <hip/hip_runtime.h>
#include <hip/hip_cooperative_groups.h>
#include <cstdio>
#include <cstdint>
namespace cg = cooperative_groups;

#define LAS __attribute__((address_space(3)))
typedef unsigned short bf16;
typedef unsigned v4u __attribute__((ext_vector_type(4)));
typedef unsigned v2u __attribute__((ext_vector_type(2)));
typedef float f32x4 __attribute__((ext_vector_type(4)));
typedef short bf16x8 __attribute__((ext_vector_type(8)));
typedef short s16x4 __attribute__((ext_vector_type(4)));

namespace pg8 {
#define PG8_LAS __attribute__((address_space(3)))
typedef unsigned short bf16_t;
constexpr int BM = 256, BK = 64, HALF = 128, HTB = HALF * BK * 2, STAGE_BYTES = 8 * HTB, NXCD = 8, WGM = 8;

__host__ __device__ __forceinline__ int lds_byte(int r, int c) { const int st = (r >> 4) * 2 + (c >> 5), rr = r & 15, cc = c & 31, ob = rr * 64 + cc * 2; return st * 1024 + (ob ^ (((ob >> 9) & 1) << 5)); }
__host__ __device__ __forceinline__ void stage_rc(int b, int& R, int& C) { const int st = b / 1024, sb = b % 1024, swz = sb ^ (((sb >> 9) & 1) << 5); R = (st >> 1) * 16 + swz / 64; C = (st & 1) * 32 + (swz % 64) / 2; }
__host__ __device__ __forceinline__ int perm32(int rho) { const int n = rho >> 4, i = rho & 15; return 8 * (i >> 2) + 4 * n + (i & 3); }

struct Unit { int pm, pn; };
struct Gemm { const bf16_t* A; const bf16_t* Bt; int M, N, K; };

struct StaticOrder {
    int nM, nN, nwg, G, c;
    __host__ __device__ void init(int M, int N, int G_, int c_) { nM = M / BM; nN = N / BM; nwg = nM * nN; G = G_; c = c_; }
    __host__ __device__ bool next(int i, Unit& u) const {
        const long L = (long)i * G + c; if (L >= nwg) return false;
        int wgid = (int)L; { const int q = nwg / NXCD, r = nwg % NXCD, xcd = wgid % NXCD, off = wgid / NXCD; wgid = (xcd < r ? xcd * (q + 1) : r * (q + 1) + (xcd - r) * q) + off; }
        const int nig = WGM * nN, gid = wgid / nig, fm = gid * WGM, gsz = (nM - fm) < WGM ? (nM - fm) : WGM;
        u.pm = fm + ((wgid % nig) % gsz); u.pn = (wgid % nig) / gsz; return true;
    }
    __device__ __forceinline__ void a_ready(const Unit&) const {}
    __device__ __forceinline__ void done(const Unit&) const {}
};

__device__ __forceinline__ unsigned cvt_pk_bf16(float lo, float hi) { unsigned r; asm volatile("v_cvt_pk_bf16_f32 %0, %1, %2" : "=v"(r) : "v"(lo), "v"(hi)); return r; }

struct EpiBf16 {
    static constexpr bool PERM = true, AFTER_DRAIN = false;
    bf16_t* O; int ldc;
    __device__ __forceinline__ void operator()(const f32x4 (&acc)[2][2][4][2], const Unit& u, int wr, int wc, int fr, int fq) const {
        const int row0 = u.pm * BM + wr * 64 + fr; const int col0 = u.pn * BM + wc * 32 + 8 * fq;
#pragma unroll
        for (int ai = 0; ai < 2; ++ai)
#pragma unroll
            for (int m = 0; m < 4; ++m) { bf16_t* rowp = O + (size_t)(row0 + ai * HALF + m * 16) * ldc + col0;
#pragma unroll
                for (int bj = 0; bj < 2; ++bj) { const f32x4 v0 = acc[ai][bj][m][0], v1 = acc[ai][bj][m][1];
                    v4u w; w.x = cvt_pk_bf16(v0[0], v0[1]); w.y = cvt_pk_bf16(v0[2], v0[3]); w.z = cvt_pk_bf16(v1[0], v1[1]); w.w = cvt_pk_bf16(v1[2], v1[3]);
                    *(v4u*)(rowp + bj * HALF) = w; } }
    }
};
struct EpiResF32 {
    static constexpr bool PERM = true, AFTER_DRAIN = false;
    float* C; const float* R; int ldc;
    __device__ __forceinline__ void operator()(const f32x4 (&acc)[2][2][4][2], const Unit& u, int wr, int wc, int fr, int fq) const {
        const int row0 = u.pm * BM + wr * 64 + fr, col0 = u.pn * BM + wc * 32 + 8 * fq;
#pragma unroll
        for (int ai = 0; ai < 2; ++ai)
#pragma unroll
            for (int m = 0; m < 4; ++m) { const size_t ro = (size_t)(row0 + ai * HALF + m * 16) * ldc + col0;
#pragma unroll
                for (int bj = 0; bj < 2; ++bj)
#pragma unroll
                    for (int n = 0; n < 2; ++n) { const f32x4 r = *(const f32x4*)(R + ro + bj * HALF + n * 4); *(f32x4*)(C + ro + bj * HALF + n * 4) = acc[ai][bj][m][n] + r; } }
    }
};
struct EpiX1 {
    static constexpr bool PERM = true, AFTER_DRAIN = false;
    const float* R; bf16_t* H2; float* rowss; int ldc;
    __device__ __forceinline__ void operator()(const f32x4 (&acc)[2][2][4][2], const Unit& u, int wr, int wc, int fr, int fq) const {
        const int row0 = u.pm * BM + wr * 64 + fr, col0 = u.pn * BM + wc * 32 + 8 * fq;
#pragma unroll
        for (int ai = 0; ai < 2; ++ai)
#pragma unroll
            for (int m = 0; m < 4; ++m) { const int row = row0 + ai * HALF + m * 16; const size_t ro = (size_t)row * ldc + col0;
                const size_t po = (size_t)((row >> 12) * 4154 + 1 + (row & 4095)) * ldc + col0;
                float ss = 0.f;
#pragma unroll
                for (int bj = 0; bj < 2; ++bj) {
                    const f32x4 r0 = __builtin_nontemporal_load((const f32x4*)(R + ro + bj * HALF)), r1 = __builtin_nontemporal_load((const f32x4*)(R + ro + bj * HALF + 4));
                    const f32x4 v0 = acc[ai][bj][m][0] + r0, v1 = acc[ai][bj][m][1] + r1;
                    v4u w; w.x = cvt_pk_bf16(v0[0], v0[1]); w.y = cvt_pk_bf16(v0[2], v0[3]); w.z = cvt_pk_bf16(v1[0], v1[1]); w.w = cvt_pk_bf16(v1[2], v1[3]);
                    *(v4u*)(H2 + po + bj * HALF) = w;
                    ss += (v0[0] * v0[0] + v0[1] * v0[1]) + (v0[2] * v0[2] + v0[3] * v0[3]) + (v1[0] * v1[0] + v1[1] * v1[1]) + (v1[2] * v1[2] + v1[3] * v1[3]); }
                ss += __shfl_xor(ss, 16); ss += __shfl_xor(ss, 32);
                if (fq == 0) atomicAdd(rowss + row, ss);
            }
    }
};
struct EpiOut {
    static constexpr bool PERM = true, AFTER_DRAIN = false;
    float* C; const bf16_t* H2; int ldc;
    __device__ __forceinline__ void operator()(const f32x4 (&acc)[2][2][4][2], const Unit& u, int wr, int wc, int fr, int fq) const {
        const int row0 = u.pm * BM + wr * 64 + fr, col0 = u.pn * BM + wc * 32 + 8 * fq;
#pragma unroll
        for (int ai = 0; ai < 2; ++ai)
#pragma unroll
            for (int m = 0; m < 4; ++m) { const int row = row0 + ai * HALF + m * 16; const size_t ro = (size_t)row * ldc + col0;
                const size_t po = (size_t)((row >> 12) * 4154 + 1 + (row & 4095)) * ldc + col0;
#pragma unroll
                for (int bj = 0; bj < 2; ++bj) {
                    const v4u h = __builtin_nontemporal_load((const v4u*)(H2 + po + bj * HALF));
                    const f32x4 r0 = (f32x4){__builtin_bit_cast(float, h.x << 16), __builtin_bit_cast(float, h.x & 0xffff0000u), __builtin_bit_cast(float, h.y << 16), __builtin_bit_cast(float, h.y & 0xffff0000u)};
                    const f32x4 r1 = (f32x4){__builtin_bit_cast(float, h.z << 16), __builtin_bit_cast(float, h.z & 0xffff0000u), __builtin_bit_cast(float, h.w << 16), __builtin_bit_cast(float, h.w & 0xffff0000u)};
                    __builtin_nontemporal_store(acc[ai][bj][m][0] + r0, (f32x4*)(C + ro + bj * HALF)); __builtin_nontemporal_store(acc[ai][bj][m][1] + r1, (f32x4*)(C + ro + bj * HALF + 4)); }
            }
    }
};
__device__ __forceinline__ float dpp_f(float oldv, float src, int) { return src + oldv; }
template <int CTRL> __device__ __forceinline__ float dppmov(float oldv, float src) {
    return __builtin_bit_cast(float, __builtin_amdgcn_update_dpp(__builtin_bit_cast(int, oldv), __builtin_bit_cast(int, src), CTRL, 0xf, 0xf, false));
}
template <int CTRL> __device__ __forceinline__ float rormov(float src) {
    return __builtin_bit_cast(float, __builtin_amdgcn_mov_dpp(__builtin_bit_cast(int, src), CTRL, 0xf, 0xf, true));
}
struct EpiConv {
    static constexpr bool PERM = true, AFTER_DRAIN = false;
    bf16_t* act; const float* cw; const float* cb; const float* rowss;
    __device__ __forceinline__ void operator()(const f32x4 (&acc_in)[2][2][4][2], const Unit& u, int wr, int wc, int fr, int fq) const {
        constexpr int NU = 11264, FF = 5632, PB = 4154;
        const int gc0 = u.pn * 128 + wc * 32 + fq * 8;
        f32x4 acc[2][2][4][2];
#pragma unroll
        for (int ai = 0; ai < 2; ++ai)
#pragma unroll
            for (int m = 0; m < 4; ++m) {
                const int p = 62 * (4 * u.pm + 2 * ai + wr) + 16 * m + fr, b = p / PB, q = p - b * PB;
                float rr = 0.f;
                if (q >= 1 && q <= 4096 && b < 4) rr = __builtin_amdgcn_rsqf(rowss[b * 4096 + q - 1] * (1.f / 2048.f) + 1e-6f);
#pragma unroll
                for (int bj = 0; bj < 2; ++bj)
#pragma unroll
                    for (int n = 0; n < 2; ++n) acc[ai][bj][m][n] = acc_in[ai][bj][m][n] * rr;
            }
        unsigned half0[2][4][2];
#pragma unroll
        for (int n = 0; n < 2; ++n) {
            const int gc = gc0 + 4 * n;
            const f32x4 wg0 = *(const f32x4*)(cw + gc), wg1 = *(const f32x4*)(cw + NU + gc), wg2 = *(const f32x4*)(cw + 2 * NU + gc), bg = *(const f32x4*)(cb + gc);
            const f32x4 wv0 = *(const f32x4*)(cw + FF + gc), wv1 = *(const f32x4*)(cw + NU + FF + gc), wv2 = *(const f32x4*)(cw + 2 * NU + FF + gc), bv = *(const f32x4*)(cb + FF + gc);
#pragma unroll
            for (int ai = 0; ai < 2; ++ai) {
                const int slab = 4 * u.pm + 2 * ai + wr, p0 = 62 * slab;
#pragma unroll
                for (int m = 0; m < 4; ++m) {
                    float o[4];
#pragma unroll
                    for (int x = 0; x < 4; ++x) {
                        const float gcur = acc[ai][0][m][n][x], vcur = acc[ai][1][m][n][x];
                        const float gtp = (m > 0 && fr == 15) ? acc[ai][0][m - 1][n][x] : gcur, vtp = (m > 0 && fr == 15) ? acc[ai][1][m - 1][n][x] : vcur;
                        const float gtn = (m < 3 && fr == 0) ? acc[ai][0][m + 1][n][x] : gcur, vtn = (m < 3 && fr == 0) ? acc[ai][1][m + 1][n][x] : vcur;
                        const float gp = rormov<0x121>(gtp), gn = rormov<0x12F>(gtn);
                        const float vp = rormov<0x121>(vtp), vn = rormov<0x12F>(vtn);
                        const float Gv = wg0[x] * gp + wg1[x] * gcur + wg2[x] * gn + bg[x];
                        const float Vv = wv0[x] * vp + wv1[x] * vcur + wv2[x] * vn + bv[x];
                        const float sg = Gv * __builtin_amdgcn_rcpf(1.f + __builtin_amdgcn_exp2f(-1.4426950408889634f * Gv));
                        o[x] = sg * Vv;
                    }
                    if (n == 0) { half0[ai][m][0] = cvt_pk_bf16(o[0], o[1]); half0[ai][m][1] = cvt_pk_bf16(o[2], o[3]); }
                    else {
                        const int rs = 16 * m + fr, p = p0 + rs, b = p / PB, q = p - b * PB;
                        if (rs >= 1 && rs <= 62 && q >= 1 && q <= 4096 && b < 4) {
                            v4u w; w.x = half0[ai][m][0]; w.y = half0[ai][m][1]; w.z = cvt_pk_bf16(o[0], o[1]); w.w = cvt_pk_bf16(o[2], o[3]);
                            *(v4u*)(act + (size_t)(b * 4096 + q - 1) * FF + gc0) = w;
                        }
                    }
                }
            }
        }
    }
};

template <class Epi, class Sched, bool ALIGN_EPI, bool SLAB>
__device__ __forceinline__ void gemm_phase(PG8_LAS unsigned char* lds, const Gemm g, const Sched& S, const Epi& E) {
    const int tid = threadIdx.x, wid = __builtin_amdgcn_readfirstlane(tid >> 6), lane = tid & 63, wr = wid >> 2, wc = wid & 3, fr = lane & 15, fq = lane >> 4;
    const int K = g.K, nt = K / BK;
    unsigned voffA[2], voffB[2];
#pragma unroll
    for (int i = 0; i < 2; ++i) { int R, C; stage_rc(tid * 16 + i * 8192, R, C); const int Rb = Epi::PERM ? ((R & ~31) + perm32(R & 31)) : R;
        const int Ra = SLAB ? (R - 2 * (R >> 6)) : R;
        voffA[i] = (unsigned)(Ra * K + C) * 2u; voffB[i] = (unsigned)(Rb * K + C) * 2u; }
    const size_t kstep = (size_t)(BK * 2);
    const size_t hstepB = (size_t)HALF * K * 2, tstepB = 2 * hstepB;
    const size_t hstepA = SLAB ? (size_t)124 * K * 2 : hstepB, tstepA = 2 * hstepA;
    const unsigned ldsw = (unsigned)wid * 1024u;
    const int aoff = lds_byte(wr * 64 + fr, fq * 8), boff = lds_byte(wc * 32 + fr, fq * 8);
#define PG8_SA(b, h) (((b) * 2 + (h)) * HTB)
#define PG8_SB(b, h) ((4 + (b) * 2 + (h)) * HTB)
#define PG8_STAGE(bufoff, gbase, voff) do { _Pragma("unroll") for (int _i = 0; _i < 2; ++_i) \
        __builtin_amdgcn_global_load_lds((const unsigned*)((const char*)(gbase) + (voff)[_i]), (PG8_LAS unsigned*)(lds + (bufoff) + ldsw + _i * 8192), 16, 0, 0); } while (0)
#define PG8_LDA(dst, b, h) do { _Pragma("unroll") for (int m = 0; m < 4; ++m) _Pragma("unroll") for (int k = 0; k < 2; ++k) dst[m][k] = *(const PG8_LAS bf16x8*)(lds + PG8_SA(b, h) + aoff + m * 2048 + k * 1024); } while (0)
#define PG8_LDB(dst, b, h) do { _Pragma("unroll") for (int n = 0; n < 2; ++n) _Pragma("unroll") for (int k = 0; k < 2; ++k) dst[n][k] = *(const PG8_LAS bf16x8*)(lds + PG8_SB(b, h) + boff + n * 2048 + k * 1024); } while (0)
#define PG8_MMA(ai, bj, At, Bt) do { __builtin_amdgcn_s_setprio(1); _Pragma("unroll") for (int m = 0; m < 4; ++m) _Pragma("unroll") for (int n = 0; n < 2; ++n) _Pragma("unroll") for (int k = 0; k < 2; ++k) \
        acc[ai][bj][m][n] = __builtin_amdgcn_mfma_f32_16x16x32_bf16(Bt[n][k], At[m][k], acc[ai][bj][m][n], 0, 0, 0); __builtin_amdgcn_s_setprio(0); } while (0)
#define PG8_WAIT_V(n) asm volatile("s_waitcnt vmcnt(" #n ")" ::: "memory")
#define PG8_WAIT_L(n) asm volatile("s_waitcnt lgkmcnt(" #n ")" ::: "memory")
#define PG8_BAR __builtin_amdgcn_s_barrier()
#define PG8_SCHED __builtin_amdgcn_sched_barrier(0)
    Unit cur, nxt; int ui = 0;
    if (!S.next(0, cur)) return;
    f32x4 acc[2][2][4][2];
#pragma unroll
    for (int a = 0; a < 2; ++a)
#pragma unroll
        for (int b = 0; b < 2; ++b)
#pragma unroll
            for (int m = 0; m < 4; ++m)
#pragma unroll
                for (int n = 0; n < 2; ++n) acc[a][b][m][n] = (f32x4){0.f, 0.f, 0.f, 0.f};
    bf16x8 At[4][2], B0[2][2], B1[2][2];
    const char* cA = (const char*)g.A + (size_t)cur.pm * tstepA; const char* cB = (const char*)g.Bt + (size_t)cur.pn * tstepB;
    S.a_ready(cur);
    PG8_STAGE(PG8_SB(0, 0), cB, voffB); PG8_STAGE(PG8_SB(0, 1), cB + hstepB, voffB); PG8_STAGE(PG8_SA(0, 0), cA, voffA); PG8_STAGE(PG8_SA(0, 1), cA + hstepA, voffA);
    if (wr == 1) PG8_BAR;
    PG8_WAIT_V(2); PG8_BAR;
    PG8_STAGE(PG8_SB(1, 0), cB + kstep, voffB); PG8_STAGE(PG8_SA(1, 0), cA + kstep, voffA); PG8_STAGE(PG8_SB(1, 1), cB + hstepB + kstep, voffB);
    PG8_WAIT_V(6); PG8_BAR;
    for (;;) {
        const bool has_next = S.next(ui + 1, nxt);
        const char* nA = has_next ? (const char*)g.A + (size_t)nxt.pm * tstepA : cA; const char* nB = has_next ? (const char*)g.Bt + (size_t)nxt.pn * tstepB : cB;
        for (int t = 0; t < nt; t += 2) {
            const bool last = (t == nt - 2);
            const char* a1 = cA + (size_t)(t + 1) * kstep;
            const char* a2 = last ? nA : cA + (size_t)(t + 2) * kstep; const char* b2 = last ? nB : cB + (size_t)(t + 2) * kstep;
            const char* a3 = a2 + kstep; const char* b3 = b2 + kstep;
            if (last && has_next) S.a_ready(nxt);
            PG8_LDB(B0, 0, 0); PG8_LDB(B1, 0, 1); PG8_SCHED; PG8_LDA(At, 0, 0); PG8_STAGE(PG8_SA(1, 1), a1 + hstepA, voffA);
            PG8_WAIT_V(8); PG8_WAIT_L(0); PG8_BAR; PG8_MMA(0, 0, At, B0); PG8_MMA(0, 1, At, B1); PG8_BAR; PG8_SCHED;
            PG8_LDA(At, 0, 1); PG8_STAGE(PG8_SB(0, 0), b2, voffB); PG8_STAGE(PG8_SB(0, 1), b2 + hstepB, voffB); PG8_STAGE(PG8_SA(0, 0), a2, voffA);
            PG8_WAIT_V(8); PG8_WAIT_L(0); PG8_BAR; PG8_MMA(1, 0, At, B0); PG8_MMA(1, 1, At, B1); PG8_BAR; PG8_SCHED;
            PG8_LDB(B0, 1, 0); PG8_LDB(B1, 1, 1); PG8_SCHED; PG8_LDA(At, 1, 0); PG8_STAGE(PG8_SA(0, 1), a2 + hstepA, voffA);
            PG8_WAIT_V(8); PG8_WAIT_L(0); PG8_BAR; PG8_MMA(0, 0, At, B0); PG8_MMA(0, 1, At, B1); PG8_BAR; PG8_SCHED;
            PG8_LDA(At, 1, 1); PG8_STAGE(PG8_SB(1, 0), b3, voffB); PG8_STAGE(PG8_SB(1, 1), b3 + hstepB, voffB); PG8_STAGE(PG8_SA(1, 0), a3, voffA);
            PG8_WAIT_V(8); PG8_WAIT_L(0); PG8_BAR; PG8_MMA(1, 0, At, B0); PG8_MMA(1, 1, At, B1); PG8_BAR; PG8_SCHED;
        }
        if constexpr (ALIGN_EPI) { if (wr == 0) PG8_BAR; }
        E(acc, cur, wr, wc, fr, fq); S.done(cur);
        if (!has_next) break;
#pragma unroll
        for (int a = 0; a < 2; ++a)
#pragma unroll
            for (int b = 0; b < 2; ++b)
#pragma unroll
                for (int m = 0; m < 4; ++m)
#pragma unroll
                    for (int n = 0; n < 2; ++n) acc[a][b][m][n] = (f32x4){0.f, 0.f, 0.f, 0.f};
        cur = nxt; cA = nA; cB = nB; ++ui;
        if constexpr (ALIGN_EPI) { if (wr == 1) PG8_BAR; }
    }
    PG8_WAIT_V(0);
    if constexpr (!ALIGN_EPI) { if (wr == 0) PG8_BAR; }
    PG8_BAR;
#undef PG8_SA
#undef PG8_SB
#undef PG8_STAGE
#undef PG8_LDA
#undef PG8_LDB
#undef PG8_MMA
#undef PG8_WAIT_V
#undef PG8_WAIT_L
#undef PG8_BAR
#undef PG8_SCHED
}
}

constexpr int NWAVES = 8, NTHR = 512;
constexpr int BATCH = 4, T = 4096, D = 2048, M = BATCH * T;
constexpr int NPROJ = 4640, NPROJ_P = 4864;
constexpr int DFF = 5632, NUP = 11264;
constexpr int C_QA = 0, C_KA = 1024, C_VA = 1280, C_QG = 1536, C_KG = 2048, C_VG = 2560, C_GG = 3584, C_LRF = 4608;
constexpr int PB = 4154, H2ROWS = 67 * 248 + 2;
constexpr float EPS = 1e-6f;
constexpr float LOG2E = 1.4426950408889634f;
constexpr float QSCALE = 0.08838834764831845f * LOG2E;
constexpr float GLA_SC = 0.08838834764831845f;

constexpr size_t MiB = 1u << 20;
constexpr size_t WS_RSS = 65536;
constexpr size_t WS_WIN = 1 * MiB, WS_WOUT = 20 * MiB, WS_WUP = 28 * MiB, WS_WDN = 72 * MiB;
constexpr size_t WS_H = 96 * MiB;
constexpr size_t WS_QA = 96 * MiB, WS_KOT = 128 * MiB;
constexpr size_t WS_PROJ = 160 * MiB;
constexpr size_t WS_MIX = 312 * MiB;
constexpr size_t WS_AB = 376 * MiB, WS_QI = 392 * MiB, WS_DV = 424 * MiB, WS_VTG = 426 * MiB, WS_KA = 458 * MiB, WS_VTA = 466 * MiB, WS_END = 474 * MiB;
constexpr size_t WS_H2 = 160 * MiB;
constexpr size_t WS_ACT = 232 * MiB;
static_assert(WS_H2 + (size_t)H2ROWS * D * 2 <= WS_ACT && WS_ACT + (size_t)M * DFF * 2 <= WS_END, "ws map");

constexpr int LDS_BYTES = 147456;
constexpr int LDS_XB = LDS_BYTES - 1024;
constexpr int W_UP_EARLY = 3072;

typedef float f32x2_t __attribute__((ext_vector_type(2)));
typedef __bf16 bf16x2_t __attribute__((ext_vector_type(2)));
__device__ __forceinline__ unsigned pk2(float lo, float hi) { f32x2_t v = {lo, hi}; bf16x2_t b = __builtin_convertvector(v, bf16x2_t); return __builtin_bit_cast(unsigned, b); }
__device__ __forceinline__ unsigned f2bf(float f) { return pk2(f, 0.f) & 0xffffu; }
__device__ __forceinline__ float bflo(unsigned w) { return __builtin_bit_cast(float, w << 16); }
__device__ __forceinline__ float bfhi(unsigned w) { return __builtin_bit_cast(float, w & 0xffff0000u); }
__device__ __forceinline__ float bf2f(unsigned short b) { return __builtin_bit_cast(float, (unsigned)b << 16); }
__device__ __forceinline__ float wave_sum(float v) {
#pragma unroll
    for (int o = 1; o < 64; o <<= 1) v += __shfl_xor(v, o);
    return v;
}
#define LDS_WAIT() asm volatile("s_waitcnt lgkmcnt(0)" ::: "memory")
#define MFMA16(a, b, c) __builtin_amdgcn_mfma_f32_16x16x32_bf16((a), (b), (c), 0, 0, 0)

struct Args {
    const float* in[17]; float* out; unsigned char* ws; int ph_lo, ph_hi;
};

__device__ __forceinline__ void transpose_load(const float* W, int N, int item, int lane, float (&tv)[32]) {
    const int nblk = N / 32, kb = item / nblk, nb = item % nblk, k0 = 64 * kb, n0 = 32 * nb;
#pragma unroll
    for (int i = 0; i < 32; ++i) { const int kk = 2 * i + (lane >> 5); tv[i] = __builtin_nontemporal_load(W + (size_t)(k0 + kk) * N + n0 + (lane & 31)); }
}
__device__ __forceinline__ void transpose_finish(int K, int N, bf16* WT, int mode, LAS float* scr, int item, int lane, const float* kgain, float (&tv)[32]) {
    const int nblk = N / 32, kb = item / nblk, nb = item % nblk, k0 = 64 * kb, n0 = 32 * nb;
    int drow0 = n0;
    if (mode == 1) drow0 = (n0 < DFF) ? (n0 / 128) * 256 + (n0 % 128) : ((n0 - DFF) / 128) * 256 + 128 + ((n0 - DFF) % 128);
    if (kgain) {
#pragma unroll
        for (int i = 0; i < 32; ++i) tv[i] *= kgain[k0 + 2 * i + (lane >> 5)];
    }
#pragma unroll
    for (int i = 0; i < 32; ++i) { const int kk = 2 * i + (lane >> 5); scr[kk * 33 + (lane & 31)] = tv[i]; }
    LDS_WAIT(); asm volatile("" ::: "memory");
    const int c = lane & 7;
#pragma unroll
    for (int j = 0; j < 4; ++j) { const int n = (lane >> 3) + 8 * j; const LAS float* s = scr + (8 * c) * 33 + n;
        v4u o; o.x = pk2(s[0 * 33], s[1 * 33]); o.y = pk2(s[2 * 33], s[3 * 33]); o.z = pk2(s[4 * 33], s[5 * 33]); o.w = pk2(s[6 * 33], s[7 * 33]);
        *(v4u*)(WT + (size_t)(drow0 + n) * K + k0 + 8 * c) = o; }
    LDS_WAIT(); asm volatile("" ::: "memory");
}
__device__ __forceinline__ void transpose_item(const float* W, int K, int N, bf16* WT, int mode, LAS float* scr, int item, int lane, const float* kgain = nullptr) {
    float tv[32]; transpose_load(W, N, item, lane, tv); transpose_finish(K, N, WT, mode, scr, item, lane, kgain, tv);
}
__device__ __forceinline__ void transpose_list(const float* W, int K, int N, bf16* WT, int mode, LAS float* scr, int it0, int stride, int nitems, int lane, const float* kgain) {
    float ta[32], tb[32];
    if (it0 < nitems) transpose_load(W, N, it0, lane, ta);
    for (int it = it0; it < nitems; it += 2 * stride) {
        const int it1 = it + stride, it2 = it + 2 * stride;
        if (it1 < nitems) transpose_load(W, N, it1, lane, tb);
        transpose_finish(K, N, WT, mode, scr, it, lane, kgain, ta);
        if (it1 < nitems) { if (it2 < nitems) transpose_load(W, N, it2, lane, ta); transpose_finish(K, N, WT, mode, scr, it1, lane, kgain, tb); }
    }
}
__device__ __forceinline__ void rms_row_to_bf16(const float* xrow, const float* gain, bf16* orow, int lane) {
    const f32x4* xr = (const f32x4*)xrow + lane; const f32x4* gr = (const f32x4*)gain + lane;
    f32x4 v[8]; float s = 0.f;
#pragma unroll
    for (int j = 0; j < 8; ++j) { v[j] = __builtin_nontemporal_load(xr + 64 * j); s += (v[j].x * v[j].x + v[j].y * v[j].y) + (v[j].z * v[j].z + v[j].w * v[j].w); }
    const float r = 1.0f / sqrtf(wave_sum(s) * (1.f / D) + EPS);
    v2u* o8 = (v2u*)orow + lane;
#pragma unroll
    for (int j = 0; j < 8; ++j) { const f32x4 g = gr[64 * j]; v2u w; w.x = pk2(v[j].x * r * g.x, v[j].y * r * g.y); w.y = pk2(v[j].z * r * g.z, v[j].w * r * g.w); o8[64 * j] = w; }
}

__device__ __forceinline__ void gla_prep_block(LAS unsigned char* L, int item0, int istride, const bf16* proj, const float* wa2f, const float* baf, const float* wa2b, const float* bab,
                                              bf16* Abuf, bf16* QIb, bf16* KOTb, float* DVb) {
    const int tid = threadIdx.x, lane = tid & 63, w = __builtin_amdgcn_readfirstlane(tid >> 6);
    LAS unsigned char* Qs = L; LAS unsigned char* Ks = L + 17408; LAS unsigned char* Gs = L + 34816; LAS float* Tot = (LAS float*)(L + 68608);
    LAS float* LRs = (LAS float*)(L + 70656); LAS unsigned char* QEs = L + 78848; LAS unsigned char* KEs = L + 96256; LAS unsigned char* KOs = L + 113664;
    v4u pq[2], pk[2]; v2u plr;
    bf16x8 wBf = (bf16x8){0, 0, 0, 0, 0, 0, 0, 0}, wBb = wBf; float biasf = 0.f, biasb = 0.f; int hprev = -1;
#define GP_LOAD(it_) do { const int b_ = (it_) >> 8, h_ = ((it_) >> 6) & 3, n_ = (it_) & 63, tk_ = b_ * T + n_ * 64; \
        _Pragma("unroll") for (int i_ = 0; i_ < 2; ++i_) { const int ch_ = tid + 512 * i_, r_ = ch_ >> 4, c_ = ch_ & 15; \
            pq[i_] = __builtin_nontemporal_load((const v4u*)(proj + (size_t)(tk_ + r_) * NPROJ_P + C_QG + h_ * 128 + c_ * 8)); \
            pk[i_] = __builtin_nontemporal_load((const v4u*)(proj + (size_t)(tk_ + r_) * NPROJ_P + C_KG + h_ * 128 + c_ * 8)); } \
        { const int idx_ = tid * 4, dir_ = idx_ >> 10, r_ = (idx_ >> 4) & 63, c_ = idx_ & 15; \
          plr = *(const v2u*)(proj + (size_t)(tk_ + r_) * NPROJ_P + C_LRF + dir_ * 16 + c_); } } while (0)
    if (item0 < 1024) GP_LOAD(item0);
#pragma unroll 1
  for (int item = item0; item < 1024; item += istride) {
    const int b = item >> 8, h = (item >> 6) & 3, n = item & 63;
    if (h != hprev) { hprev = h; const int d = h * 128 + 16 * w + (lane & 15), lg = lane >> 4;
        if (lg < 2) { float a[8], c[8];
#pragma unroll
            for (int j = 0; j < 8; ++j) { a[j] = wa2f[(lg * 8 + j) * 512 + d]; c[j] = wa2b[(lg * 8 + j) * 512 + d]; }
            v4u pa, pc; pa.x = pk2(a[0], a[1]); pa.y = pk2(a[2], a[3]); pa.z = pk2(a[4], a[5]); pa.w = pk2(a[6], a[7]);
            pc.x = pk2(c[0], c[1]); pc.y = pk2(c[2], c[3]); pc.z = pk2(c[4], c[5]); pc.w = pk2(c[6], c[7]);
            wBf = __builtin_bit_cast(bf16x8, pa); wBb = __builtin_bit_cast(bf16x8, pc); }
        biasf = baf[d]; biasb = bab[d]; }
    __syncthreads();
#pragma unroll
    for (int i = 0; i < 2; ++i) { const int ch = tid + 512 * i, r = ch >> 4, c = ch & 15;
        *(LAS v4u*)(Qs + r * 272 + c * 16) = pq[i]; *(LAS v4u*)(Ks + r * 272 + c * 16) = pk[i]; }
    { const int idx = tid * 4, dir = idx >> 10, r = (idx >> 4) & 63, c = idx & 15;
      *(LAS v2u*)((LAS unsigned char*)LRs + (dir * 64 + r) * 32 + c * 2) = plr; }
    if (item + istride < 1024) GP_LOAD(item + istride);
    __syncthreads();
#pragma unroll 1
    for (int dir = 0; dir < 2; ++dir) {
        const int ci = (((b * 4 + h) * 2 + dir) * 64 + n);
        {
            const int dl = lane & 15, lg = lane >> 4;
            const float bias = dir ? biasb : biasf;
            float g[4][4];
#pragma unroll
            for (int tt = 0; tt < 4; ++tt) {
                bf16x8 a = (bf16x8){0, 0, 0, 0, 0, 0, 0, 0};
                if (lg < 2) a = *(const LAS bf16x8*)((LAS unsigned char*)LRs + (dir * 64 + 16 * tt + dl) * 32 + lg * 16);
                const f32x4 z4 = MFMA16(a, dir ? wBb : wBf, ((f32x4){0.f, 0.f, 0.f, 0.f}));
#pragma unroll
                for (int jj = 0; jj < 4; ++jj) { const float z = z4[jj] + bias; g[tt][jj] = (fminf(z, 0.f) - __logf(1.f + __expf(-fabsf(z)))) * (1.f / 16.f); }
            }
            float carry = 0.f;
#pragma unroll
            for (int k = 0; k < 4; ++k) {
                const int tt = dir ? 3 - k : k;
                float p[4];
                if (dir == 0) { p[0] = g[tt][0]; p[1] = p[0] + g[tt][1]; p[2] = p[1] + g[tt][2]; p[3] = p[2] + g[tt][3]; }
                else { p[3] = g[tt][3]; p[2] = p[3] + g[tt][2]; p[1] = p[2] + g[tt][1]; p[0] = p[1] + g[tt][0]; }
                const float gt = dir ? p[0] : p[3];
                const float t0 = __shfl(gt, dl), t1 = __shfl(gt, dl + 16), t2 = __shfl(gt, dl + 32), t3 = __shfl(gt, dl + 48);
                float excl;
                if (dir == 0) excl = (lg > 0 ? t0 : 0.f) + (lg > 1 ? t1 : 0.f) + (lg > 2 ? t2 : 0.f);
                else excl = (lg < 3 ? t3 : 0.f) + (lg < 2 ? t2 : 0.f) + (lg < 1 ? t1 : 0.f);
                const float base = carry + excl;
#pragma unroll
                for (int jj = 0; jj < 4; ++jj) *(LAS float*)(Gs + (16 * tt + 4 * lg + jj) * 528 + (16 * w + dl) * 4) = base + p[jj];
                carry += (t0 + t1) + (t2 + t3);
            }
            __syncthreads();
        }
        {
            const int t = tid >> 3, d0 = (tid & 7) * 16;
            const int tref = dir ? 31 : 32, tlast = dir ? 0 : 63;
#pragma unroll
            for (int hf = 0; hf < 2; ++hf) {
                const int dd = d0 + 8 * hf;
                const v4u q8 = *(const LAS v4u*)(Qs + t * 272 + dd * 2), k8 = *(const LAS v4u*)(Ks + t * 272 + dd * 2);
                float qv[8], kv[8], cc[8], cr[8], cl[8];
                qv[0] = bflo(q8.x); qv[1] = bfhi(q8.x); qv[2] = bflo(q8.y); qv[3] = bfhi(q8.y); qv[4] = bflo(q8.z); qv[5] = bfhi(q8.z); qv[6] = bflo(q8.w); qv[7] = bfhi(q8.w);
                kv[0] = bflo(k8.x); kv[1] = bfhi(k8.x); kv[2] = bflo(k8.y); kv[3] = bfhi(k8.y); kv[4] = bflo(k8.z); kv[5] = bfhi(k8.z); kv[6] = bflo(k8.w); kv[7] = bfhi(k8.w);
#pragma unroll
                for (int x4 = 0; x4 < 2; ++x4) {
                    const f32x4 a = *(const LAS f32x4*)(Gs + t * 528 + (dd + 4 * x4) * 4), r4 = *(const LAS f32x4*)(Gs + tref * 528 + (dd + 4 * x4) * 4), l4 = *(const LAS f32x4*)(Gs + tlast * 528 + (dd + 4 * x4) * 4);
#pragma unroll
                    for (int x = 0; x < 4; ++x) { cc[4 * x4 + x] = a[x]; cr[4 * x4 + x] = r4[x]; cl[4 * x4 + x] = l4[x]; }
                }
                float qe[8], ke[8], qi[8], ko[8];
#pragma unroll
                for (int x = 0; x < 8; ++x) { const float qq = qv[x] * GLA_SC;
                    qe[x] = qq * __expf(cc[x] - cr[x]); ke[x] = kv[x] * __expf(cr[x] - cc[x]); qi[x] = qq * __expf(cc[x]); ko[x] = kv[x] * __expf(cl[x] - cc[x]); }
                v4u o;
                o.x = pk2(qe[0], qe[1]); o.y = pk2(qe[2], qe[3]); o.z = pk2(qe[4], qe[5]); o.w = pk2(qe[6], qe[7]); *(LAS v4u*)(QEs + t * 272 + dd * 2) = o;
                o.x = pk2(ke[0], ke[1]); o.y = pk2(ke[2], ke[3]); o.z = pk2(ke[4], ke[5]); o.w = pk2(ke[6], ke[7]); *(LAS v4u*)(KEs + t * 272 + dd * 2) = o;
                o.x = pk2(ko[0], ko[1]); o.y = pk2(ko[2], ko[3]); o.z = pk2(ko[4], ko[5]); o.w = pk2(ko[6], ko[7]); *(LAS v4u*)(KOs + t * 272 + dd * 2) = o;
                o.x = pk2(qi[0], qi[1]); o.y = pk2(qi[2], qi[3]); o.z = pk2(qi[4], qi[5]); o.w = pk2(qi[6], qi[7]); *(v4u*)(QIb + ((size_t)ci * 64 + t) * 128 + dd) = o;
            }
            if (tid < 128) DVb[(size_t)ci * 128 + tid] = __expf(*(const LAS float*)(Gs + tlast * 528 + tid * 4));
            __syncthreads();
        }
        {
            const int d = tid >> 2, tq = tid & 3;
            unsigned short v[16];
#pragma unroll
            for (int i = 0; i < 16; ++i) v[i] = *(const LAS unsigned short*)(KOs + (tq * 16 + i) * 272 + d * 2);
            v4u o0, o1;
            o0.x = v[0] | ((unsigned)v[1] << 16); o0.y = v[2] | ((unsigned)v[3] << 16); o0.z = v[4] | ((unsigned)v[5] << 16); o0.w = v[6] | ((unsigned)v[7] << 16);
            o1.x = v[8] | ((unsigned)v[9] << 16); o1.y = v[10] | ((unsigned)v[11] << 16); o1.z = v[12] | ((unsigned)v[13] << 16); o1.w = v[14] | ((unsigned)v[15] << 16);
            bf16* dst = KOTb + ((size_t)ci * 128 + d) * 64 + tq * 16;
            *(v4u*)dst = o0; *(v4u*)(dst + 8) = o1;
        }
        {
#pragma unroll
            for (int tt = 0; tt < 2; ++tt) {
                const int tile = 2 * w + tt, jt = tile >> 2, it = tile & 3;
                f32x4 acc = (f32x4){0.f, 0.f, 0.f, 0.f};
#pragma unroll
                for (int kk = 0; kk < 4; ++kk) {
                    const bf16x8 a = *(const LAS bf16x8*)(KEs + (16 * jt + (lane & 15)) * 272 + (32 * kk + (lane >> 4) * 8) * 2);
                    const bf16x8 bq = *(const LAS bf16x8*)(QEs + (16 * it + (lane & 15)) * 272 + (32 * kk + (lane >> 4) * 8) * 2);
                    acc = MFMA16(a, bq, acc);
                }
                const int i = 16 * it + (lane & 15), jb = 16 * jt + (lane >> 4) * 4;
                float o[4];
#pragma unroll
                for (int jj = 0; jj < 4; ++jj) { const int j = jb + jj; const bool keep = dir ? (j > i) : (j <= i); o[jj] = keep ? acc[jj] : 0.f; }
                v2u wv2; wv2.x = pk2(o[0], o[1]); wv2.y = pk2(o[2], o[3]);
                *(v2u*)(Abuf + ((size_t)ci * 64 + i) * 64 + jb) = wv2;
            }
        }
        __syncthreads();
    }
  }
#undef GP_LOAD
}

template <bool TCONV> __device__ __forceinline__ void gla_scan_item(LAS unsigned char* L, int wi, const bf16* Abuf, const bf16* QIb, const bf16* KOTb, const float* DVb, const bf16* VTG, bf16* of, bf16* ob,
                                              const float* w_up, const float* kgain, bf16* Wt_up, int tgw, int tngw) {
    const int tid = threadIdx.x, lane = tid & 63, w = __builtin_amdgcn_readfirstlane(tid >> 6);
    const int chain = wi >> 2, sl = wi & 3, dir = chain & 1, bh = chain >> 1, b = bh >> 2, h = bh & 3;
    bf16* odir = dir ? ob : of;
    constexpr int BUFB = 54784, OA = 0, OQ = 9216, OK_ = 26624, OV = 45056, ODV = 54272, OST = 2 * BUFB, STB = 17408;
    v4u rA[2], rQ[2][2], rK[2][2], rV[2]; float rD[2];
#define GS_LOAD(s_, nn) do { const size_t ci_ = (size_t)chain * 64 + (nn); \
        rA[s_] = *(const v4u*)(Abuf + (ci_ * 64 + (tid >> 3)) * 64 + (tid & 7) * 8); \
        _Pragma("unroll") for (int i_ = 0; i_ < 2; ++i_) { const int ch_ = tid + 512 * i_; \
            rQ[s_][i_] = *(const v4u*)(QIb + (ci_ * 64 + (ch_ >> 4)) * 128 + (ch_ & 15) * 8); \
            rK[s_][i_] = *(const v4u*)(KOTb + (ci_ * 128 + (ch_ >> 3)) * 64 + (ch_ & 7) * 8); } \
        rV[s_] = *(const v4u*)(VTG + (((size_t)bh * 64 + (nn)) * 256 + sl * 64 + (tid >> 3)) * 64 + (tid & 7) * 8); \
        rD[s_] = DVb[ci_ * 128 + (tid & 127)]; } while (0)
#define GS_STORE(s_, bi) do { LAS unsigned char* B_ = L + (bi) * BUFB; \
        *(LAS v4u*)(B_ + OA + (tid >> 3) * 144 + (tid & 7) * 16) = rA[s_]; \
        _Pragma("unroll") for (int i_ = 0; i_ < 2; ++i_) { const int ch_ = tid + 512 * i_; \
            *(LAS v4u*)(B_ + OQ + (ch_ >> 4) * 272 + (ch_ & 15) * 16) = rQ[s_][i_]; \
            *(LAS v4u*)(B_ + OK_ + (ch_ >> 3) * 144 + (ch_ & 7) * 16) = rK[s_][i_]; } \
        *(LAS v4u*)(B_ + OV + (tid >> 3) * 144 + (tid & 7) * 16) = rV[s_]; \
        if (tid < 128) *(LAS float*)(B_ + ODV + tid * 4) = rD[s_]; } while (0)
    __syncthreads();
    for (int i = tid; i < STB / 4; i += NTHR) ((LAS unsigned*)(L + OST))[i] = 0u;
    f32x4 S[4];
#pragma unroll
    for (int e = 0; e < 4; ++e) S[e] = (f32x4){0.f, 0.f, 0.f, 0.f};
    { const int n0 = dir ? 63 : 0; GS_LOAD(0, n0); GS_STORE(0, 0); const int n1 = dir ? 62 : 1; GS_LOAD(1, n1); }
    __syncthreads();
    const int it = w >> 1, eh = w & 1;
    constexpr int I_UPC = (D / 64) * (NUP / 32);
    float tv[32], tl[8]; int tk0 = 0, tdrow = 0, tl_k = 0; bool tvalid = false, tl_valid = false; const float* twp = w_up; bf16* tl_dst = Wt_up;
#pragma unroll 1
    for (int step4 = 0; step4 < 16; ++step4) {
#pragma unroll
      for (int par = 0; par < 4; ++par) {
        const int step = 4 * step4 + par, cur = par & 1;
        if (TCONV && par == 0 && tl_valid) { const f32x4 g0_ = *(const f32x4*)(kgain + tl_k), g1_ = *(const f32x4*)(kgain + tl_k + 4); v4u o_;
            o_.x = pk2(tl[0] * g0_[0], tl[1] * g0_[1]); o_.y = pk2(tl[2] * g0_[2], tl[3] * g0_[3]); o_.z = pk2(tl[4] * g1_[0], tl[5] * g1_[1]); o_.w = pk2(tl[6] * g1_[2], tl[7] * g1_[3]);
            *(v4u*)tl_dst = o_; tl_valid = false; }
        const int n = dir ? 63 - step : step;
        { const int nn = dir ? (n >= 2 ? n - 2 : 0) : (n <= 61 ? n + 2 : 63); GS_LOAD(par & 1, nn); }
        if constexpr (TCONV) {
            if (par == 0) { int it_ = tgw + step4 * tngw; tvalid = tgw >= 0 && it_ < I_UPC; it_ = tvalid ? it_ : I_UPC - 1;
                const int kb_ = it_ / (NUP / 32), nb_ = it_ - kb_ * (NUP / 32); tk0 = 64 * kb_ + 32 * (lane >> 5); const int n0_ = 32 * nb_;
                tdrow = ((n0_ < DFF) ? (n0_ / 128) * 256 + (n0_ % 128) : ((n0_ - DFF) / 128) * 256 + 128 + ((n0_ - DFF) % 128)) + (lane & 31);
                twp = w_up + (size_t)tk0 * NUP + n0_ + (lane & 31); }
#pragma unroll
            for (int j_ = 0; j_ < 8; ++j_) tv[8 * par + j_] = twp[(size_t)(8 * par + j_) * NUP];
        }
        LAS unsigned char* Bc = L + cur * BUFB; LAS unsigned char* Stc = L + OST + cur * STB; LAS unsigned char* Stn = L + OST + (cur ^ 1) * STB;
        f32x4 acc0 = (f32x4){0.f, 0.f, 0.f, 0.f}, acc1 = acc0;
#pragma unroll
        for (int kk = 0; kk < 2; ++kk) { const bf16x8 a = *(const LAS bf16x8*)(Bc + OA + (16 * it + (lane & 15)) * 144 + (32 * kk + (lane >> 4) * 8) * 2);
            const bf16x8 v0 = *(const LAS bf16x8*)(Bc + OV + (32 * eh + (lane & 15)) * 144 + (32 * kk + (lane >> 4) * 8) * 2);
            const bf16x8 v1 = *(const LAS bf16x8*)(Bc + OV + (32 * eh + 16 + (lane & 15)) * 144 + (32 * kk + (lane >> 4) * 8) * 2);
            acc0 = MFMA16(v0, a, acc0); acc1 = MFMA16(v1, a, acc1); }
#pragma unroll
        for (int kk = 0; kk < 4; ++kk) { const bf16x8 a = *(const LAS bf16x8*)(Bc + OQ + (16 * it + (lane & 15)) * 272 + (32 * kk + (lane >> 4) * 8) * 2);
            const bf16x8 s0 = *(const LAS bf16x8*)(Stc + (32 * eh + (lane & 15)) * 272 + (32 * kk + (lane >> 4) * 8) * 2);
            const bf16x8 s1 = *(const LAS bf16x8*)(Stc + (32 * eh + 16 + (lane & 15)) * 272 + (32 * kk + (lane >> 4) * 8) * 2);
            acc0 = MFMA16(s0, a, acc0); acc1 = MFMA16(s1, a, acc1); }
        { const size_t tok = (size_t)b * T + n * 64 + 16 * it + (lane & 15); const int col = h * 256 + sl * 64 + 32 * eh + (lane >> 4) * 4;
          v2u w0, w1; w0.x = pk2(acc0[0], acc0[1]); w0.y = pk2(acc0[2], acc0[3]); w1.x = pk2(acc1[0], acc1[1]); w1.y = pk2(acc1[2], acc1[3]);
          *(v2u*)(odir + tok * 1024 + col) = w0; *(v2u*)(odir + tok * 1024 + col + 16) = w1; }
        { const f32x4 dsc = *(const LAS f32x4*)(Bc + ODV + (16 * w + (lane >> 4) * 4) * 4);
          bf16x8 ka[2];
#pragma unroll
          for (int kk = 0; kk < 2; ++kk) ka[kk] = *(const LAS bf16x8*)(Bc + OK_ + (16 * w + (lane & 15)) * 144 + (32 * kk + (lane >> 4) * 8) * 2);
#pragma unroll
          for (int e = 0; e < 4; ++e) { S[e] = S[e] * dsc;
#pragma unroll
              for (int kk = 0; kk < 2; ++kk) { const bf16x8 vf = *(const LAS bf16x8*)(Bc + OV + (16 * e + (lane & 15)) * 144 + (32 * kk + (lane >> 4) * 8) * 2); S[e] = MFMA16(ka[kk], vf, S[e]); }
              v2u p; p.x = pk2(S[e][0], S[e][1]); p.y = pk2(S[e][2], S[e][3]);
              *(LAS v2u*)(Stn + (16 * e + (lane & 15)) * 272 + (16 * w + (lane >> 4) * 4) * 2) = p; } }
        if (TCONV && par == 3) {
            if (tvalid) { bf16* d_ = Wt_up + (size_t)tdrow * D + tk0;
#pragma unroll
                for (int c_ = 0; c_ < 3; ++c_) { const f32x4 g0_ = *(const f32x4*)(kgain + tk0 + 8 * c_), g1_ = *(const f32x4*)(kgain + tk0 + 8 * c_ + 4); v4u o_;
                    o_.x = pk2(tv[8 * c_] * g0_[0], tv[8 * c_ + 1] * g0_[1]); o_.y = pk2(tv[8 * c_ + 2] * g0_[2], tv[8 * c_ + 3] * g0_[3]);
                    o_.z = pk2(tv[8 * c_ + 4] * g1_[0], tv[8 * c_ + 5] * g1_[1]); o_.w = pk2(tv[8 * c_ + 6] * g1_[2], tv[8 * c_ + 7] * g1_[3]);
                    *(v4u*)(d_ + 8 * c_) = o_; } }
            tl_valid = tvalid; tl_dst = Wt_up + (size_t)tdrow * D + tk0 + 24; tl_k = tk0 + 24;
#pragma unroll
            for (int j_ = 0; j_ < 8; ++j_) tl[j_] = tv[24 + j_];
        }
        if (step < 63) GS_STORE((par + 1) & 1, cur ^ 1);
        __syncthreads();
      }
    }
    if (TCONV && tl_valid) { const f32x4 g0_ = *(const f32x4*)(kgain + tl_k), g1_ = *(const f32x4*)(kgain + tl_k + 4); v4u o_;
        o_.x = pk2(tl[0] * g0_[0], tl[1] * g0_[1]); o_.y = pk2(tl[2] * g0_[2], tl[3] * g0_[3]); o_.z = pk2(tl[4] * g1_[0], tl[5] * g1_[1]); o_.w = pk2(tl[6] * g1_[2], tl[7] * g1_[3]);
        *(v4u*)tl_dst = o_; tl_valid = false; }
#undef GS_LOAD
#undef GS_STORE
}

__device__ __forceinline__ void attn_item(LAS unsigned char* L, int ai, const bf16* qa, const bf16* ka, const bf16* VTA, const float* sink, bf16* mix) {
    const int tid = threadIdx.x, lane = tid & 63, w = __builtin_amdgcn_readfirstlane(tid >> 6);
    const int qq = ai & 3, kvh = (ai >> 2) & 1, n = (ai >> 3) & 31, b = ai >> 8;
    const int g = w >> 1, hq = kvh * 4 + g, qrow0 = n * 128 + qq * 32 + (w & 1) * 16;
    LAS unsigned char* Ks = L; LAS unsigned char* Vs = L + 34816;
    bf16x8 qf[4];
#pragma unroll
    for (int kk = 0; kk < 4; ++kk) qf[kk] = *(const bf16x8*)(qa + ((size_t)b * T + qrow0 + (lane & 15)) * 1024 + hq * 128 + 32 * kk + (lane >> 4) * 8);
    float mrun = sink[hq] * LOG2E, lsum = 1.f; f32x4 O[8];
#pragma unroll
    for (int dt = 0; dt < 8; ++dt) O[dt] = (f32x4){0.f, 0.f, 0.f, 0.f};
    const int kb_lo = n > 0 ? n - 1 : 0, kb_hi = n < 31 ? n + 1 : 31;
    v4u rk[4], rv[4];
#define AT_LOAD(kb_) do { _Pragma("unroll") for (int i_ = 0; i_ < 4; ++i_) { const int ch_ = tid + 512 * i_, r_ = ch_ >> 4, c_ = ch_ & 15; \
        rk[i_] = *(const v4u*)(ka + ((size_t)b * T + (kb_) * 128 + r_) * 256 + kvh * 128 + c_ * 8); \
        rv[i_] = *(const v4u*)(VTA + ((((size_t)b * 2 + kvh) * 32 + (kb_)) * 128 + r_) * 128 + c_ * 8); } } while (0)
    AT_LOAD(kb_lo);
    const int qpos = qrow0 + (lane & 15);
#pragma unroll 1
    for (int kb = kb_lo; kb <= kb_hi; ++kb) {
        __syncthreads();
#pragma unroll
        for (int i = 0; i < 4; ++i) { const int ch = tid + 512 * i, r = ch >> 4, c = ch & 15;
            *(LAS v4u*)(Ks + r * 272 + c * 16) = rk[i]; *(LAS v4u*)(Vs + r * 272 + c * 16) = rv[i]; }
        __syncthreads();
        if (kb < kb_hi) AT_LOAD(kb + 1);
#pragma unroll 1
        for (int kh = 0; kh < 2; ++kh) {
            const int kbase = kb * 128 + kh * 64;
            if (kbase + 63 < qrow0 - 128 || kbase > qrow0 + 15 + 128) continue;
            const LAS unsigned char* Kh = Ks + kh * (64 * 272); const LAS unsigned char* Vh = Vs + kh * 128;
            f32x4 s[4];
#pragma unroll
            for (int kt = 0; kt < 4; ++kt) { f32x4 acc = (f32x4){0.f, 0.f, 0.f, 0.f};
#pragma unroll
                for (int kk = 0; kk < 4; ++kk) { const bf16x8 kf = *(const LAS bf16x8*)(Kh + (16 * kt + (lane & 15)) * 272 + (32 * kk + (lane >> 4) * 8) * 2); acc = MFMA16(kf, qf[kk], acc); }
                s[kt] = acc; }
            float mx = -INFINITY;
#pragma unroll
            for (int kt = 0; kt < 4; ++kt)
#pragma unroll
                for (int jj = 0; jj < 4; ++jj) { const int dl = kbase + 16 * kt + (lane >> 4) * 4 + jj - qpos; if (dl > 128 || dl < -128) s[kt][jj] = -INFINITY; mx = fmaxf(mx, s[kt][jj]); }
            mx = fmaxf(mx, __shfl_xor(mx, 16)); mx = fmaxf(mx, __shfl_xor(mx, 32));
            const float mnew = fmaxf(mrun, mx), alpha = __builtin_amdgcn_exp2f(mrun - mnew);
            mrun = mnew;
            float rs = 0.f;
#pragma unroll
            for (int kt = 0; kt < 4; ++kt)
#pragma unroll
                for (int jj = 0; jj < 4; ++jj) { const float p = __builtin_amdgcn_exp2f(s[kt][jj] - mnew); s[kt][jj] = p; rs += p; }
            rs += __shfl_xor(rs, 16); rs += __shfl_xor(rs, 32);
            lsum = lsum * alpha + rs;
#pragma unroll
            for (int dt = 0; dt < 8; ++dt) O[dt] = O[dt] * alpha;
#pragma unroll
            for (int ks = 0; ks < 2; ++ks) {
                v4u pw; pw.x = pk2(s[2 * ks][0], s[2 * ks][1]); pw.y = pk2(s[2 * ks][2], s[2 * ks][3]); pw.z = pk2(s[2 * ks + 1][0], s[2 * ks + 1][1]); pw.w = pk2(s[2 * ks + 1][2], s[2 * ks + 1][3]);
                const bf16x8 pf = __builtin_bit_cast(bf16x8, pw);
#pragma unroll
                for (int dt = 0; dt < 8; ++dt) {
                    const LAS unsigned char* vp = Vh + (16 * dt + (lane & 15)) * 272 + (32 * ks + (lane >> 4) * 4) * 2;
                    const v2u v0 = *(const LAS v2u*)vp, v1 = *(const LAS v2u*)(vp + 32);
                    v4u vw; vw.x = v0.x; vw.y = v0.y; vw.z = v1.x; vw.w = v1.y;
                    O[dt] = MFMA16(__builtin_bit_cast(bf16x8, vw), pf, O[dt]);
                }
            }
        }
    }
#undef AT_LOAD
    { const float inv = 1.f / lsum;
      bf16* orow = mix + ((size_t)b * T + qrow0 + (lane & 15)) * 2048 + hq * 128 + (lane >> 4) * 4;
#pragma unroll
      for (int dt = 0; dt < 8; ++dt) { const f32x4 o = O[dt] * inv; v2u wv2; wv2.x = pk2(o[0], o[1]); wv2.y = pk2(o[2], o[3]); *(v2u*)(orow + 16 * dt) = wv2; } }
}

#define XB_TMO      128
#define XB_XCNT(j)  (256  + 64 * (j))
#define XB_XSUB(j)  (1280 + 64 * (j))
#define XB_XGEN(j)  (2304 + 64 * (j))
#define XB_TOP      3328
#define XB_TOPGEN   3392
#define XCD_BAR_WORDS 3456
#define XB_SPIN_CAP (1u << 22)
__device__ __forceinline__ unsigned xb_ld(unsigned* p)              { return __hip_atomic_load(p, __ATOMIC_RELAXED, __HIP_MEMORY_SCOPE_AGENT); }
__device__ __forceinline__ unsigned xb_add(unsigned* p, unsigned v) { return __hip_atomic_fetch_add(p, v, __ATOMIC_RELAXED, __HIP_MEMORY_SCOPE_AGENT); }
__device__ __forceinline__ unsigned xb_xcc_id() { return (unsigned)__builtin_amdgcn_s_getreg((3 << 11) | 20) & 0xFu; }
#define XB_SPIN(cond, bar) do { unsigned _sp = 0; while (cond) { __builtin_amdgcn_s_sleep(1); \
    if ((++_sp & 255u) == 0u) { if (xb_ld(&(bar)[XB_TMO])) break; if (_sp > XB_SPIN_CAP) { atomicAdd(&(bar)[XB_TMO], 1u); break; } } } } while (0)
struct XcdBarrier { unsigned* bar; unsigned x; volatile LAS unsigned* st; };
__device__ __forceinline__ XcdBarrier xcd_barrier_post(unsigned* bar, volatile LAS unsigned* st) {
    XcdBarrier b; b.bar = bar; b.x = xb_xcc_id(); b.st = st;
    if (threadIdx.x == 0) (void)xb_add(&bar[XB_XCNT(b.x)], 1u);
    return b;
}
__device__ __forceinline__ void xcd_barrier_complete(unsigned* bar, unsigned x, unsigned& nloc, unsigned& nx) {
    const unsigned G = gridDim.x * gridDim.y * gridDim.z;
    unsigned sum, cnt, mine, sp = 0u;
    for (;;) {
        sum = 0u; cnt = 0u; mine = 0u;
#pragma unroll
        for (unsigned j = 0; j < 16; ++j) { const unsigned c = xb_ld(&bar[XB_XCNT(j)]); sum += c; cnt += (c > 0u) ? 1u : 0u; mine = (j == x) ? c : mine; }
        if (sum == G) break;
        __builtin_amdgcn_s_sleep(1);
        if ((++sp & 255u) == 0u) { if (xb_ld(&bar[XB_TMO])) break; if (sp > XB_SPIN_CAP) { atomicAdd(&bar[XB_TMO], 1u); break; } }
    }
    nloc = mine > 0u ? mine : 1u; nx = cnt > 0u ? cnt : 1u;
}
__device__ __forceinline__ void xcd_barrier(const XcdBarrier& b) {
    asm volatile("s_waitcnt vmcnt(0)" ::: "memory");
    __syncthreads();
    if (threadIdx.x == 0) {
        unsigned* bar = b.bar;
        __builtin_amdgcn_s_waitcnt(0);
        unsigned nloc = b.st[0], nx = b.st[1];
        if (nloc == 0u) { xcd_barrier_complete(bar, b.x, nloc, nx); b.st[0] = nloc; b.st[1] = nx; }
        const unsigned old = xb_add(&bar[XB_XSUB(b.x)], 1u);
        const unsigned gen = old / nloc;
        if (old + 1u == (gen + 1u) * nloc) {
            __builtin_amdgcn_fence(__ATOMIC_RELEASE, "agent");
            asm volatile("s_waitcnt vmcnt(0)" ::: "memory");
            const unsigned og = xb_add(&bar[XB_TOP], 1u);
            const unsigned tg = og / nx;
            if (og + 1u == (tg + 1u) * nx) xb_add(&bar[XB_TOPGEN], 1u);
            else XB_SPIN(xb_ld(&bar[XB_TOPGEN]) == tg, bar);
            __builtin_amdgcn_fence(__ATOMIC_ACQUIRE, "agent");
            xb_add(&bar[XB_XGEN(b.x)], 1u);
            asm volatile("s_waitcnt vmcnt(0)" ::: "memory");
        } else {
            XB_SPIN(xb_ld(&bar[XB_XGEN(b.x)]) == gen, bar);
            __builtin_amdgcn_fence(__ATOMIC_ACQUIRE, "agent");
            asm volatile("s_waitcnt vmcnt(0)" ::: "memory");
        }
    }
    __syncthreads();
}

__global__ void __launch_bounds__(NTHR, 2) hymba_fwd(Args args) {
    extern __shared__ __attribute__((aligned(16))) unsigned char lds_raw[];
    LAS unsigned char* L = (LAS unsigned char*)lds_raw;
    cg::grid_group grid = cg::this_grid();
    const int tid = threadIdx.x, lane = tid & 63, wave = __builtin_amdgcn_readfirstlane(tid >> 6);
    const int G = gridDim.x, bx = blockIdx.x;
    const int gw = bx * NWAVES + wave, NGW = G * NWAVES;
#define KARG(i) (((volatile const __attribute__((address_space(4))) unsigned long long*)__builtin_amdgcn_kernarg_segment_ptr())[i])
#define GAS __attribute__((address_space(1)))
#define INP(i) ((const float*)(GAS const float*)KARG(i))
#define WSP(off) ((unsigned char*)((GAS unsigned char*)KARG(18) + (off)))
#define OUTP ((float*)(GAS float*)KARG(17))
    const int lo = args.ph_lo, hi = args.ph_hi;
#ifndef REPEAT_MASK
#define REPEAT_MASK 0
#endif
#ifndef PHASE_MASK
#define PHASE_MASK 0x1ff
#endif
#define IN(k) (((PHASE_MASK >> (k)) & 1) && lo <= (k) && (k) < hi)
#define SEAMX(k, k2) do { if (IN(k) && IN(k2)) xcd_barrier(xbar); } while (0)
#define SEAM(k) SEAMX(k, (k) + 1)
    if (tid < 64) ((LAS unsigned*)(L + LDS_XB))[tid] = 0u;
    __syncthreads();
    const XcdBarrier xbar = xcd_barrier_post((unsigned*)WSP(0), (volatile LAS unsigned*)(L + LDS_XB));

    if (lo < 0) grid.sync();
    if (IN(0)) for (int rep_ = 0; rep_ < 1 + ((REPEAT_MASK >> 0) & 1); ++rep_) { if (rep_) grid.sync();
        const float* x = INP(0); const float* norm1_g = INP(1); const float* w_in = INP(2); const float* w_out = INP(11); const float* w_up = INP(13); const float* w_down = INP(16); const float* norm2_g = INP(12);
        bf16* Wt_in = (bf16*)WSP(WS_WIN); bf16* Wt_out = (bf16*)WSP(WS_WOUT); bf16* Wt_up = (bf16*)WSP(WS_WUP); bf16* Wt_dn = (bf16*)WSP(WS_WDN); bf16* Hb = (bf16*)WSP(WS_H);
        LAS float* scr = (LAS float*)(L + wave * 16384);
        constexpr int I_IN = (D / 64) * (NPROJ / 32), I_UP = (D / 64) * (NUP / 32);
        const int NITEMS = I_IN + (G == 256 ? 0 : I_UP);
        for (int it = gw; it < NITEMS; it += NGW) {
            int r = it;
            if (r < I_IN) { transpose_item(w_in, D, NPROJ, Wt_in, 0, scr, r, lane); continue; } r -= I_IN;
            transpose_item(w_up, D, NUP, Wt_up, 1, scr, r, lane, norm2_g);
        }
        { v4u z = (v4u){0u, 0u, 0u, 0u}; v4u* p = (v4u*)(Wt_in + (size_t)NPROJ * D); const int nv = (NPROJ_P - NPROJ) * D / 8;
          for (int i = bx * NTHR + tid; i < nv; i += G * NTHR) p[i] = z; }
        for (int m = gw; m < M; m += 2 * NGW) {
            const int m2 = m + NGW;
            const f32x4* xa = (const f32x4*)(x + (size_t)m * D) + lane; const f32x4* xb = (const f32x4*)(x + (size_t)(m2 < M ? m2 : m) * D) + lane; const f32x4* gr = (const f32x4*)norm1_g + lane;
            f32x4 va[8], vb[8]; float sa = 0.f, sb = 0.f;
#pragma unroll
            for (int j = 0; j < 8; ++j) { va[j] = xa[64 * j]; vb[j] = xb[64 * j]; }
#pragma unroll
            for (int j = 0; j < 8; ++j) { sa += (va[j].x * va[j].x + va[j].y * va[j].y) + (va[j].z * va[j].z + va[j].w * va[j].w); sb += (vb[j].x * vb[j].x + vb[j].y * vb[j].y) + (vb[j].z * vb[j].z + vb[j].w * vb[j].w); }
            const float ra = __builtin_amdgcn_rsqf(wave_sum(sa) * (1.f / D) + EPS), rb = __builtin_amdgcn_rsqf(wave_sum(sb) * (1.f / D) + EPS);
            v2u* oa = (v2u*)(Hb + (size_t)m * D) + lane; v2u* ob2 = (v2u*)(Hb + (size_t)m2 * D) + lane;
#pragma unroll
            for (int j = 0; j < 8; ++j) { const f32x4 g = gr[64 * j];
                v2u w; w.x = pk2(va[j].x * ra * g.x, va[j].y * ra * g.y); w.y = pk2(va[j].z * ra * g.z, va[j].w * ra * g.w); oa[64 * j] = w;
                if (m2 < M) { v2u w2; w2.x = pk2(vb[j].x * rb * g.x, vb[j].y * rb * g.y); w2.y = pk2(vb[j].z * rb * g.z, vb[j].w * rb * g.w); ob2[64 * j] = w2; } }
        }
    }
    SEAM(0);
    if (IN(1)) for (int rep_ = 0; rep_ < 1 + ((REPEAT_MASK >> 1) & 1); ++rep_) { if (rep_) grid.sync();
        bf16* Wt_in = (bf16*)WSP(WS_WIN); bf16* Hb = (bf16*)WSP(WS_H); bf16* proj = (bf16*)WSP(WS_PROJ);
        pg8::Gemm g{Hb, Wt_in, M, NPROJ_P, D}; pg8::StaticOrder S; S.init(M, NPROJ_P, G, bx);
        pg8::EpiBf16 E{proj, NPROJ_P};
        pg8::gemm_phase<pg8::EpiBf16, pg8::StaticOrder, true, false>(L, g, S, E);
        { const int nwg = (M / 256) * (NPROJ_P / 256), full = nwg / G, rem = nwg - full * G;
          const float* w_out = INP(11); bf16* Wt_out = (bf16*)WSP(WS_WOUT); LAS float* scr = (LAS float*)(L + wave * 16384);
          constexpr int I_OUT = (D / 64) * (D / 32);
          if (rem > 0) { if (bx >= rem) {
              for (int it = (bx - rem) * NWAVES + wave; it < I_OUT; it += (G - rem) * NWAVES) transpose_item(w_out, D, D, Wt_out, 0, scr, it, lane);
              if (G == 256) {
                  const float* w_up = INP(13); const float* norm2_g = INP(12); bf16* Wt_up = (bf16*)WSP(WS_WUP);
                  for (int it = (bx - rem) * NWAVES + wave; it < W_UP_EARLY; it += (G - rem) * NWAVES) transpose_item(w_up, D, NUP, Wt_up, 1, scr, it, lane, norm2_g);
              } } }
          else for (int it = gw; it < I_OUT; it += NGW) transpose_item(w_out, D, D, Wt_out, 0, scr, it, lane);
        }
    }
    SEAM(1);
    if (IN(2)) for (int rep_ = 0; rep_ < 1 + ((REPEAT_MASK >> 2) & 1); ++rep_) { if (rep_) grid.sync();
        const float* qn_g = INP(3); const float* kn_g = INP(4); const float* wa2f = INP(6); const float* baf = INP(7); const float* wa2b = INP(8); const float* bab = INP(9);
        bf16* proj = (bf16*)WSP(WS_PROJ); bf16* qa = (bf16*)WSP(WS_QA); bf16* KOTb = (bf16*)WSP(WS_KOT); bf16* Abuf = (bf16*)WSP(WS_AB); bf16* QIb = (bf16*)WSP(WS_QI);
        float* DVb = (float*)WSP(WS_DV); bf16* VTG = (bf16*)WSP(WS_VTG); bf16* ka = (bf16*)WSP(WS_KA); bf16* VTA = (bf16*)WSP(WS_VTA);
        gla_prep_block(L, bx, G, proj, wa2f, baf, wa2b, bab, Abuf, QIb, KOTb, DVb);
        __syncthreads();
        {
            const float inv = exp2f(-(float)lane * (13.287712379549449f / 64.f));
            const float gq1 = qn_g[lane], gq2 = qn_g[lane + 64], gk1 = kn_g[lane], gk2 = kn_g[lane + 64];
            unsigned short r1[10], r2[10], n1[10], n2[10];
            if (gw < M) { const bf16* prow = proj + (size_t)gw * NPROJ_P;
#pragma unroll
                for (int hd = 0; hd < 10; ++hd) { r1[hd] = prow[hd * 128 + lane]; r2[hd] = prow[hd * 128 + 64 + lane]; } }
            for (int tok = gw; tok < M; tok += NGW) {
                { const int tn = tok + NGW < M ? tok + NGW : tok; const bf16* prow = proj + (size_t)tn * NPROJ_P;
#pragma unroll
                  for (int hd = 0; hd < 10; ++hd) { n1[hd] = prow[hd * 128 + lane]; n2[hd] = prow[hd * 128 + 64 + lane]; } }
                const int t = tok & (T - 1);
                const float ang = (float)t * inv;
                double rev = (double)ang * 0.15915494309189535; rev -= rint(rev);
                const float fr = (float)rev;
                const float sn = __builtin_amdgcn_sinf(fr), cs = __builtin_amdgcn_cosf(fr);
#pragma unroll
                for (int hd = 0; hd < 10; ++hd) {
                    const int c0 = hd * 128;
                    const float x1 = bf2f(r1[hd]), x2 = bf2f(r2[hd]);
                    const float r = __builtin_amdgcn_rsqf(wave_sum(x1 * x1 + x2 * x2) * (1.f / 128.f) + EPS);
                    const float y1 = x1 * r * (hd < 8 ? gq1 : gk1), y2 = x2 * r * (hd < 8 ? gq2 : gk2);
                    float o1 = y1 * cs - y2 * sn, o2 = y2 * cs + y1 * sn;
                    if (hd < 8) { o1 *= QSCALE; o2 *= QSCALE; bf16* q = qa + (size_t)tok * 1024 + c0; q[lane] = (bf16)f2bf(o1); q[lane + 64] = (bf16)f2bf(o2); }
                    else { bf16* k = ka + (size_t)tok * 256 + (hd - 8) * 128; k[lane] = (bf16)f2bf(o1); k[lane + 64] = (bf16)f2bf(o2); }
                }
#pragma unroll
                for (int hd = 0; hd < 10; ++hd) { r1[hd] = n1[hd]; r2[hd] = n2[hd]; }
            }
        }
        {
            LAS unsigned char* tl = L + wave * 9216;
            for (int ti = gw; ti < 256 * 20; ti += NGW) {
                const int rt = ti / 20, ct = ti % 20, tok0 = rt * 64;
                const int srccol = ct < 4 ? C_VA + ct * 64 : C_VG + (ct - 4) * 64;
#pragma unroll
                for (int i = 0; i < 8; ++i) { const int r = (lane >> 3) + 8 * i, c8 = lane & 7;
                    *(LAS v4u*)(tl + r * 144 + c8 * 16) = __builtin_nontemporal_load((const v4u*)(proj + (size_t)(tok0 + r) * NPROJ_P + srccol + c8 * 8)); }
                LDS_WAIT(); asm volatile("" ::: "memory");
                const int bb = tok0 / T, tpos = tok0 % T;
#pragma unroll
                for (int i = 0; i < 8; ++i) {
                    const int o = lane + 64 * i, cidx = o >> 3, tg = o & 7;
                    unsigned short v[8];
#pragma unroll
                    for (int jj = 0; jj < 8; ++jj) v[jj] = *(const LAS unsigned short*)(tl + (tg * 8 + jj) * 144 + cidx * 2);
                    v4u ov; ov.x = v[0] | ((unsigned)v[1] << 16); ov.y = v[2] | ((unsigned)v[3] << 16); ov.z = v[4] | ((unsigned)v[5] << 16); ov.w = v[6] | ((unsigned)v[7] << 16);
                    if (ct < 4) { const int kb = tpos >> 7, koff = tpos & 127, kvh = ct >> 1, d = (ct & 1) * 64 + cidx;
                        *(v4u*)(VTA + ((((size_t)bb * 2 + kvh) * 32 + kb) * 128 + d) * 128 + koff + tg * 8) = ov; }
                    else { const int cgi = ct - 4, h = cgi >> 2, e = (cgi & 3) * 64 + cidx, n = tpos >> 6;
                        *(v4u*)(VTG + ((((size_t)bb * 4 + h) * 64 + n) * 256 + e) * 64 + tg * 8) = ov; }
                }
                LDS_WAIT(); asm volatile("" ::: "memory");
            }
        }
    }
    SEAM(2);
    if (IN(3)) for (int rep_ = 0; rep_ < 1 + ((REPEAT_MASK >> 3) & 1); ++rep_) { if (rep_) grid.sync();
        const float* sink = INP(5); bf16* of = (bf16*)OUTP; bf16* ob = of + (size_t)M * 1024;
        bf16* qa = (bf16*)WSP(WS_QA); bf16* KOTb = (bf16*)WSP(WS_KOT); bf16* Abuf = (bf16*)WSP(WS_AB); bf16* QIb = (bf16*)WSP(WS_QI); bf16* mix = (bf16*)WSP(WS_MIX);
        float* DVb = (float*)WSP(WS_DV); bf16* VTG = (bf16*)WSP(WS_VTG); bf16* ka = (bf16*)WSP(WS_KA); bf16* VTA = (bf16*)WSP(WS_VTA);
        if (G == 256) {
            const int xq = bx & 7, j = bx >> 3;
            if (j < 16) gla_scan_item<false>(L, xq * 16 + j, Abuf, QIb, KOTb, DVb, VTG, of, ob, nullptr, nullptr, nullptr, -1, 1);
            else {
                const int aidx = xq * 16 + (j - 16);
                for (int ai = aidx; ai < 1024; ai += 128) attn_item(L, ai, qa, ka, VTA, sink, mix);
                __syncthreads();
                { const float* w_up = INP(13); const float* norm2_g = INP(12); bf16* Wt_up = (bf16*)WSP(WS_WUP); LAS float* scr = (LAS float*)(L + wave * 16384);
                  constexpr int I_UP = (D / 64) * (NUP / 32);
                  transpose_list(w_up, D, NUP, Wt_up, 1, scr, W_UP_EARLY + aidx * NWAVES + wave, 128 * NWAVES, I_UP, lane, norm2_g); }
            }
        } else {
            for (int wi = bx; wi < 128; wi += G) gla_scan_item<false>(L, wi, Abuf, QIb, KOTb, DVb, VTG, of, ob, nullptr, nullptr, nullptr, -1, 1);
            for (int ai = bx; ai < 1024; ai += G) attn_item(L, ai, qa, ka, VTA, sink, mix);
        }
    }
    SEAM(3);
    if (IN(4)) for (int rep_ = 0; rep_ < 1 + ((REPEAT_MASK >> 4) & 1); ++rep_) { if (rep_) grid.sync();
        const float* gon_g = INP(10); const bf16* of = (const bf16*)OUTP; const bf16* ob = of + (size_t)M * 1024; bf16* proj = (bf16*)WSP(WS_PROJ); bf16* mix = (bf16*)WSP(WS_MIX);
        for (int it0 = gw; it0 < M * 4; it0 += 4 * NGW) {
            v2u a[4], c[4], gt[4]; size_t o[4]; int tk[4], hh[4];
#pragma unroll
            for (int u = 0; u < 4; ++u) { const int it = it0 + u * NGW < M * 4 ? it0 + u * NGW : it0; tk[u] = it >> 2; hh[u] = it & 3;
                o[u] = (size_t)tk[u] * 1024 + hh[u] * 256 + lane * 4;
                a[u] = __builtin_nontemporal_load((const v2u*)(of + o[u])); c[u] = __builtin_nontemporal_load((const v2u*)(ob + o[u])); gt[u] = __builtin_nontemporal_load((const v2u*)(proj + (size_t)tk[u] * NPROJ_P + C_GG + hh[u] * 256 + lane * 4)); }
            const f32x4 gn = *(const f32x4*)(gon_g + lane * 4);
#pragma unroll
            for (int u = 0; u < 4; ++u) {
                if (u > 0 && it0 + u * NGW >= M * 4) break;
                const f32x4 v = (f32x4){bflo(a[u].x) + bflo(c[u].x), bfhi(a[u].x) + bfhi(c[u].x), bflo(a[u].y) + bflo(c[u].y), bfhi(a[u].y) + bfhi(c[u].y)};
                const float r = __builtin_amdgcn_rsqf(wave_sum((v.x * v.x + v.y * v.y) + (v.z * v.z + v.w * v.w)) * (1.f / 256.f) + EPS);
                float gv[4] = {bflo(gt[u].x), bfhi(gt[u].x), bflo(gt[u].y), bfhi(gt[u].y)}, y[4];
#pragma unroll
                for (int k = 0; k < 4; ++k) { const float sg = gv[k] * __builtin_amdgcn_rcpf(1.f + __expf(-gv[k])); y[k] = v[k] * r * gn[k] * sg; }
                v2u wv2; wv2.x = pk2(y[0], y[1]); wv2.y = pk2(y[2], y[3]);
                *(v2u*)(mix + (size_t)tk[u] * 2048 + 1024 + hh[u] * 256 + lane * 4) = wv2;
            }
        }
    }
    SEAM(4);
    if (IN(5)) for (int rep_ = 0; rep_ < 1 + ((REPEAT_MASK >> 5) & 1); ++rep_) { if (rep_) grid.sync();
        const float* x = INP(0); float* out = OUTP; bf16* mix = (bf16*)WSP(WS_MIX); bf16* Wt_out = (bf16*)WSP(WS_WOUT); bf16* H2 = (bf16*)WSP(WS_H2); float* rowss = (float*)WSP(WS_RSS);
        for (int p = gw; p < H2ROWS; p += NGW) { const int b = p / PB, q = p - b * PB;
            if (b >= 4 || q < 1 || q > T) { v2u z; z.x = 0u; z.y = 0u; v2u* o8 = (v2u*)(H2 + (size_t)p * D) + lane;
#pragma unroll
                for (int j = 0; j < 8; ++j) o8[64 * j] = z; } }
        pg8::Gemm g{mix, Wt_out, M, D, D}; pg8::StaticOrder S; S.init(M, D, G, bx);
        pg8::EpiX1 E{x, H2, rowss, D};
        pg8::gemm_phase<pg8::EpiX1, pg8::StaticOrder, true, false>(L, g, S, E);
    }
    SEAMX(5, 7);
    if (IN(7)) for (int rep_ = 0; rep_ < 1 + ((REPEAT_MASK >> 7) & 1); ++rep_) { if (rep_) grid.sync();
        const float* conv_w = INP(14); const float* conv_b = INP(15); bf16* H2 = (bf16*)WSP(WS_H2); bf16* Wt_up = (bf16*)WSP(WS_WUP); bf16* act = (bf16*)WSP(WS_ACT); const float* rowss = (const float*)WSP(WS_RSS);
        pg8::Gemm g{H2, Wt_up, 67 * 256, NUP, D}; pg8::StaticOrder S; S.init(67 * 256, NUP, G, bx);
        pg8::EpiConv E{act, conv_w, conv_b, rowss};
        pg8::gemm_phase<pg8::EpiConv, pg8::StaticOrder, true, true>(L, g, S, E);
        { const int nwg = 67 * (NUP / 256), full = nwg / G, rem = nwg - full * G;
          const float* w_down = INP(16); bf16* Wt_dn = (bf16*)WSP(WS_WDN); LAS float* scr = (LAS float*)(L + wave * 16384);
          constexpr int I_DN = (DFF / 64) * (D / 32);
          if (rem > 0) { if (bx >= rem) for (int it = (bx - rem) * NWAVES + wave; it < I_DN; it += (G - rem) * NWAVES) transpose_item(w_down, DFF, D, Wt_dn, 0, scr, it, lane); }
          else for (int it = gw; it < I_DN; it += NGW) transpose_item(w_down, DFF, D, Wt_dn, 0, scr, it, lane);
        }
    }
    SEAM(7);
    if (IN(8)) for (int rep_ = 0; rep_ < 1 + ((REPEAT_MASK >> 8) & 1); ++rep_) { if (rep_) grid.sync();
        float* out = OUTP; bf16* act = (bf16*)WSP(WS_ACT); bf16* Wt_dn = (bf16*)WSP(WS_WDN);
        pg8::Gemm g{act, Wt_dn, M, D, DFF}; pg8::StaticOrder S; S.init(M, D, G, bx);
        pg8::EpiOut E{out, (const bf16*)WSP(WS_H2), D};
        pg8::gemm_phase<pg8::EpiOut, pg8::StaticOrder, true, false>(L, g, S, E);
    }
#undef IN
#undef SEAM
}

#ifndef MK_N_LAUNCHES
#define MK_N_LAUNCHES 1
#endif

extern "C" void kernel_launch(void* const* d_in, const int* in_sizes, int n_in, void* d_out, int out_size, void* d_ws, size_t ws_size, hipStream_t stream) {
    static int grid = 0;
    if (grid == 0) {
        if (n_in != 17 || out_size != M * D || ws_size < WS_END) { fprintf(stderr, "kernel_launch: unexpected shapes (n_in %d out %d ws %zu)\n", n_in, out_size, ws_size); grid = -1; return; }
        int dev = 0, cus = 0, per_cu = 0;
        hipGetDevice(&dev);
        hipDeviceGetAttribute(&cus, hipDeviceAttributeMultiprocessorCount, dev);
        if (hipFuncSetAttribute((const void*)hymba_fwd, hipFuncAttributeMaxDynamicSharedMemorySize, LDS_BYTES) != hipSuccess) { fprintf(stderr, "kernel_launch: hipFuncSetAttribute failed\n"); grid = -1; return; }
        if (hipOccupancyMaxActiveBlocksPerMultiprocessor(&per_cu, (const void*)hymba_fwd, NTHR, LDS_BYTES) != hipSuccess || per_cu < 1) { fprintf(stderr, "kernel_launch: occupancy query says %d\n", per_cu); per_cu = 1; }
        (void)hipGetLastError();
        if (per_cu > 1) per_cu = 1;
        grid = cus * per_cu;
        if (grid > 256) grid = 256;
    }
    if (grid < 0) return;
    if (hipMemsetAsync(d_ws, 0, 131072, stream) != hipSuccess) { fprintf(stderr, "kernel_launch: memset failed\n"); return; }
    Args a{};
    for (int i = 0; i < 17; ++i) a.in[i] = (const float*)d_in[i];
    a.out = (float*)d_out; a.ws = (unsigned char*)d_ws;
#if MK_N_LAUNCHES == 1
    a.ph_lo = 0; a.ph_hi = 9;
    void* kargs[] = {&a};
    hipError_t e = hipLaunchCooperativeKernel((const void*)hymba_fwd, dim3(grid), dim3(NTHR), kargs, LDS_BYTES, stream);
    if (e != hipSuccess) fprintf(stderr, "cooperative launch failed: %s (grid %d)\n", hipGetErrorString(e), grid);
#else
    for (int p = 0; p < 9; ++p) { a.ph_lo = p; a.ph_hi = p + 1; hipLaunchKernelGGL(hymba_fwd, dim3(grid), dim3(NTHR), LDS_BYTES, stream, a); }
#endif
}
```
